# Optimizing an MI355X kernel written in HIP

```python
import math
import jax, jax.numpy as jnp
from jax import lax
import numpy as np

D_MODEL = 1024
BATCH = 16
SEQ = 2048
DEPTH = 2

GRID_W = 64
N_BRANCH = 4
BRANCH_W = 512
EPS = 1e-6

DN_HEADS = 4
DN_DK = 128
DN_DV = 128
DN_CONV = 5
DN_CHUNK = 64
NA_HEADS = 8
NA_DH = 64
NA_ROWS = 8
NA_COLS = 16
GA_HEADS = 4
GA_KV_HEADS = 2
GA_DH = 128
GA_BLOCK = 128
ROPE_THETA = 10000.0
ML_HEADS = 4
ML_DK = 64
ML_DV = 128
ML_CHUNK = 64

PROJ_SIZES = (
    DN_HEADS * (2 * DN_DK + DN_DV),
    2 * DN_HEADS,
    2 * DN_HEADS,
    BRANCH_W,
    3 * NA_HEADS * NA_DH,
    BRANCH_W,
    GA_HEADS * GA_DH,
    GA_KV_HEADS * GA_DH,
    GA_KV_HEADS * GA_DH,
    BRANCH_W,
    ML_HEADS * ML_DK,
    ML_HEADS * ML_DK,
    ML_HEADS * ML_DV,
    2 * ML_HEADS,
    2 * ML_HEADS,
    ML_HEADS * ML_DV,
    BRANCH_W,
    N_BRANCH * D_MODEL,
)

kernel_name = "hybrid_gated_parallel_encoder"

F32 = jnp.float32


def _rms(x, g):
    xf = x.astype(F32)
    y = xf * lax.rsqrt(jnp.mean(xf * xf, axis=-1, keepdims=True) + EPS)
    return (y * g.astype(F32)).astype(x.dtype)


def _l2n(x):
    return x * lax.rsqrt(jnp.sum(x * x, axis=-1, keepdims=True) + EPS)


def _heads(x, h):
    B, S, _ = x.shape
    return x.reshape(B, S, h, -1).transpose(0, 2, 1, 3)


def _merge_heads(x):
    B, H, S, d = x.shape
    return x.transpose(0, 2, 1, 3).reshape(B, S, H * d)


def _split(p, sizes):
    out, o = [], 0
    for s in sizes:
        out.append(p[..., o:o + s])
        o += s
    return out


def _centred_conv(x, w):
    K = w.shape[0]
    S = x.shape[1]
    pad = K // 2
    xp = jnp.pad(x, ((0, 0), (pad, pad), (0, 0)))
    out = xp[:, 0:S] * w[0]
    for j in range(1, K):
        out = out + xp[:, j:j + S] * w[j]
    return out


def _gated_delta(q, k, v, g, beta):
    B, H, S, dk = q.shape
    dv = v.shape[-1]
    C = DN_CHUNK
    N = S // C
    q = q.reshape(B, H, N, C, dk)
    k = k.reshape(B, H, N, C, dk)
    v = v.reshape(B, H, N, C, dv)
    g = g.reshape(B, H, N, C)
    beta = beta.reshape(B, H, N, C)
    gc = jnp.cumsum(g, axis=-1)
    causal = jnp.tril(jnp.ones((C, C), bool))
    strict = jnp.tril(jnp.ones((C, C), bool), -1)
    diff = gc[..., :, None] - gc[..., None, :]
    decay = jnp.where(causal, jnp.exp(jnp.where(causal, diff, 0.0)), 0.0)
    kk = jnp.einsum('bhnid,bhnjd->bhnij', k, k)
    a_mat = jnp.eye(C, dtype=q.dtype) + jnp.where(strict, beta[..., :, None] * kk * decay, 0.0)
    rhs = jnp.concatenate([v * beta[..., None], k * (beta * jnp.exp(gc))[..., None]], axis=-1)
    sol = lax.linalg.triangular_solve(a_mat, rhs, left_side=True, lower=True, unit_diagonal=True)
    u, w = sol[..., :dv], sol[..., dv:]
    qk = jnp.einsum('bhnid,bhnjd->bhnij', q, k) * decay
    q_dec = q * jnp.exp(gc)[..., None]
    k_dec = k * jnp.exp(gc[..., -1:] - gc)[..., None]
    g_tot = jnp.exp(gc[..., -1])
    xs = tuple(jnp.moveaxis(t, 2, 0) for t in (qk, q_dec, k_dec, u, w, g_tot))

    def step(state, inp):
        qk_n, qd_n, kd_n, u_n, w_n, gt_n = inp
        v_new = u_n - jnp.einsum('bhcd,bhde->bhce', w_n, state)
        o = jnp.einsum('bhcd,bhde->bhce', qd_n, state) + jnp.einsum('bhij,bhje->bhie', qk_n, v_new)
        state = state * gt_n[..., None, None] + jnp.einsum('bhcd,bhce->bhde', kd_n, v_new)
        return state, o

    s0 = jnp.zeros((B, H, dk, dv), q.dtype)
    _, o = lax.scan(step, s0, xs)
    return jnp.moveaxis(o, 0, 2).reshape(B, H, S, dv)


def _mixer_deltanet(qkv, a_pre, b_pre, z, conv_w, a_log, dt_bias, norm_g):
    B, S, _ = qkv.shape
    qkv = jax.nn.silu(_centred_conv(qkv, conv_w))
    q, k, v = _split(qkv, (DN_HEADS * DN_DK, DN_HEADS * DN_DK, DN_HEADS * DN_DV))
    q = _l2n(_heads(q, DN_HEADS).astype(F32)) * (DN_DK ** -0.5)
    k = _l2n(_heads(k, DN_HEADS).astype(F32))
    v = _heads(v, DN_HEADS).astype(F32)
    a_pre = a_pre.reshape(B, S, 2, DN_HEADS).transpose(2, 0, 3, 1).astype(F32)
    b_pre = b_pre.reshape(B, S, 2, DN_HEADS).transpose(2, 0, 3, 1).astype(F32)
    g = -jnp.exp(a_log.astype(F32))[:, None, :, None] * jax.nn.softplus(a_pre + dt_bias.astype(F32)[:, None, :, None])
    beta = jax.nn.sigmoid(b_pre)
    o_f = _gated_delta(q, k, v, g[0], beta[0])
    fl = lambda t: jnp.flip(t, axis=2)
    o_b = fl(_gated_delta(fl(q), fl(k), fl(v), fl(g[1]), fl(beta[1])))
    o = _rms(o_f + o_b, norm_g)
    return _merge_heads(o).astype(z.dtype) * jax.nn.silu(z)


def _neighbourhood_attention(q, k, v, rpb):
    B, H, S, dh = q.shape
    rows = S // GRID_W
    kr = min(NA_ROWS, rows)
    qg = q.reshape(B, H, rows, GRID_W, dh)
    kg = k.reshape(B, H, rows, GRID_W, dh)
    vg = v.reshape(B, H, rows, GRID_W, dh)
    r = jnp.arange(rows)
    r0 = jnp.clip(r - kr // 2, 0, rows - kr)
    key_rows = r0[:, None] + jnp.arange(kr)[None, :]
    kw = kg[:, :, key_rows]
    vw = vg[:, :, key_rows]
    s = jnp.einsum('bhrqd,bhrkwd->bhrqkw', qg, kw).astype(F32) * (dh ** -0.5)
    c = jnp.arange(GRID_W)
    c0 = jnp.clip(c - NA_COLS // 2, 0, GRID_W - NA_COLS)
    in_win = (c[None, :] >= c0[:, None]) & (c[None, :] < c0[:, None] + NA_COLS)
    row_off = key_rows - r[:, None] + NA_ROWS - 1
    col_off = jnp.clip(c[None, :] - c[:, None], -(NA_COLS - 1), NA_COLS - 1) + NA_COLS - 1
    bias = rpb[:, row_off[:, None, :, None], col_off[None, :, None, :]]
    s = jnp.where(in_win[:, None, :], s + bias[None].astype(F32), -jnp.inf)
    p = jax.nn.softmax(s.reshape(B, H, rows, GRID_W, kr * GRID_W), axis=-1)
    p = p.reshape(B, H, rows, GRID_W, kr, GRID_W).astype(v.dtype)
    o = jnp.einsum('bhrqkw,bhrkwd->bhrqd', p, vw)
    return o.reshape(B, H, S, dh)


def _mixer_natten(qkv, z, q_g, k_g, rpb):
    q, k, v = _split(qkv, (NA_HEADS * NA_DH,) * 3)
    q = _rms(_heads(q, NA_HEADS), q_g)
    k = _rms(_heads(k, NA_HEADS), k_g)
    v = _heads(v, NA_HEADS)
    o = _neighbourhood_attention(q, k, v, rpb)
    return _merge_heads(o) * jax.nn.silu(z)


def _rope_tables(S, dtype):
    t = jnp.arange(S)
    row = (t // GRID_W).astype(F32)
    col = (t % GRID_W).astype(F32)
    m = GA_DH // 4
    inv = ROPE_THETA ** (-jnp.arange(m, dtype=F32) / m)
    ar = row[:, None] * inv
    ac = col[:, None] * inv
    return (jnp.cos(ar).astype(dtype), jnp.sin(ar).astype(dtype),
            jnp.cos(ac).astype(dtype), jnp.sin(ac).astype(dtype))


def _rope_axis(x, cos, sin):
    m = x.shape[-1] // 2
    x1, x2 = x[..., :m], x[..., m:]
    return jnp.concatenate([x1 * cos - x2 * sin, x1 * sin + x2 * cos], axis=-1)


def _axial_rope(x, cr, sr, cc, sc):
    half = x.shape[-1] // 2
    return jnp.concatenate([_rope_axis(x[..., :half], cr, sr), _rope_axis(x[..., half:], cc, sc)], axis=-1)


def _gqa_blocked(q, k, v):
    B, Hk, G, S, dh = q.shape
    nb = S // GA_BLOCK
    qb = q.reshape(B, Hk, G, nb, GA_BLOCK, dh).transpose(3, 0, 1, 2, 4, 5)

    def one(qi):
        s = jnp.einsum('bkgqd,bksd->bkgqs', qi, k).astype(F32) * (dh ** -0.5)
        p = jax.nn.softmax(s, axis=-1).astype(v.dtype)
        return jnp.einsum('bkgqs,bksd->bkgqd', p, v)

    o = lax.map(one, qb)
    return o.transpose(1, 2, 3, 0, 4, 5).reshape(B, Hk * G, S, dh)


def _mixer_gqa(q, k, v, z, q_g, k_g, rope):
    B, S, _ = q.shape
    q = _axial_rope(_rms(_heads(q, GA_HEADS), q_g), *rope)
    k = _axial_rope(_rms(_heads(k, GA_KV_HEADS), k_g), *rope)
    v = _heads(v, GA_KV_HEADS)
    q = q.reshape(B, GA_KV_HEADS, GA_HEADS // GA_KV_HEADS, S, GA_DH)
    o = _gqa_blocked(q, k, v)
    return _merge_heads(o) * jax.nn.silu(z)


def _mlstm_chunked(q, k, v, ig, lf):
    B, H, S, dk = q.shape
    dv = v.shape[-1]
    C = ML_CHUNK
    N = S // C
    q = q.reshape(B, H, N, C, dk)
    k = k.reshape(B, H, N, C, dk)
    v = v.reshape(B, H, N, C, dv)
    ig = ig.reshape(B, H, N, C)
    bcum = jnp.cumsum(lf.reshape(B, H, N, C), axis=-1)
    xs = tuple(jnp.moveaxis(t, 2, 0) for t in (q, k, v, ig, bcum))
    causal = jnp.tril(jnp.ones((C, C), bool))

    def step(carry, inp):
        c_st, n_st, m_st = carry
        q_n, k_n, v_n, ig_n, b_n = inp
        d_log = jnp.where(causal, b_n[..., :, None] - b_n[..., None, :] + ig_n[..., None, :], -jnp.inf)
        m_inter = b_n + m_st[..., None]
        m = jnp.maximum(jnp.max(d_log, axis=-1), m_inter)
        s = jnp.einsum('bhid,bhjd->bhij', q_n, k_n) * jnp.exp(d_log - m[..., None])
        inter = jnp.exp(m_inter - m)
        numer = inter[..., None] * jnp.einsum('bhid,bhde->bhie', q_n, c_st) + jnp.einsum('bhij,bhje->bhie', s, v_n)
        denom = inter * jnp.einsum('bhid,bhd->bhi', q_n, n_st) + jnp.sum(s, axis=-1)
        h = numer / jnp.maximum(jnp.abs(denom), jnp.exp(-m))[..., None]
        b_last = b_n[..., -1]
        w_log = b_last[..., None] - b_n + ig_n
        m_new = jnp.maximum(b_last + m_st, jnp.max(w_log, axis=-1))
        dec = jnp.exp(b_last + m_st - m_new)
        wk = k_n * jnp.exp(w_log - m_new[..., None])[..., None]
        c_st = dec[..., None, None] * c_st + jnp.einsum('bhcd,bhce->bhde', wk, v_n)
        n_st = dec[..., None] * n_st + jnp.sum(wk, axis=-2)
        return (c_st, n_st, m_new), h

    init = (jnp.zeros((B, H, dk, dv), q.dtype), jnp.zeros((B, H, dk), q.dtype), jnp.zeros((B, H), q.dtype))
    _, h = lax.scan(step, init, xs)
    return jnp.moveaxis(h, 0, 2).reshape(B, H, S, dv)


def _mixer_mlstm(q, k, v, i_pre, f_pre, o_pre, z, i_bias, f_bias, norm_g):
    B, S, _ = q.shape
    q = _heads(q, ML_HEADS).astype(F32)
    k = _heads(k, ML_HEADS).astype(F32) * (ML_DK ** -0.5)
    v = _heads(v, ML_HEADS).astype(F32)
    ig = i_pre.reshape(B, S, 2, ML_HEADS).transpose(2, 0, 3, 1).astype(F32) + i_bias.astype(F32)[:, None, :, None]
    lf = jax.nn.log_sigmoid(f_pre.reshape(B, S, 2, ML_HEADS).transpose(2, 0, 3, 1).astype(F32)
                            + f_bias.astype(F32)[:, None, :, None])
    h_f = _mlstm_chunked(q, k, v, ig[0], lf[0])
    fl = lambda t: jnp.flip(t, axis=2)
    h_b = fl(_mlstm_chunked(fl(q), fl(k), fl(v), fl(ig[1]), fl(lf[1])))
    h = _merge_heads(_rms(h_f + h_b, norm_g)).astype(z.dtype)
    return jax.nn.sigmoid(o_pre) * h * jax.nn.silu(z)


def setup_inputs(seed: int = 0) -> dict:
    key = jax.random.key(seed)
    ks = jax.random.split(key, 18)

    def nrm(k, shape, s):
        return s * jax.random.normal(k, shape, F32)

    proj_w = sum(PROJ_SIZES)
    dt = jnp.exp(jax.random.uniform(ks[5], (DEPTH, 2, DN_HEADS), F32, math.log(1e-3), math.log(1e-1)))
    return {
        "x": jax.random.normal(ks[0], (BATCH, SEQ, D_MODEL), F32),
        "norm_g": 1.0 + nrm(ks[1], (DEPTH, D_MODEL), 0.02),
        "w_in": nrm(ks[2], (DEPTH, D_MODEL, proj_w), D_MODEL ** -0.5),
        "conv_a": nrm(ks[3], (DEPTH, DN_CONV, DN_HEADS * (2 * DN_DK + DN_DV)), DN_CONV ** -0.5),
        "dn_a_log": jnp.log(jax.random.uniform(ks[4], (DEPTH, 2, DN_HEADS), F32, 1.0, 16.0)),
        "dn_dt_bias": dt + jnp.log(-jnp.expm1(-dt)),
        "dn_norm_g": 1.0 + nrm(ks[6], (DEPTH, DN_DV), 0.02),
        "na_q_norm": 1.0 + nrm(ks[7], (DEPTH, NA_DH), 0.02),
        "na_k_norm": 1.0 + nrm(ks[8], (DEPTH, NA_DH), 0.02),
        "na_rpb": nrm(ks[9], (DEPTH, NA_HEADS, 2 * NA_ROWS - 1, 2 * NA_COLS - 1), 0.02),
        "ga_q_norm": 1.0 + nrm(ks[10], (DEPTH, GA_DH), 0.02),
        "ga_k_norm": 1.0 + nrm(ks[11], (DEPTH, GA_DH), 0.02),
        "ml_i_bias": nrm(ks[12], (DEPTH, 2, ML_HEADS), 0.1),
        "ml_f_bias": jax.random.uniform(ks[13], (DEPTH, 2, ML_HEADS), F32, 3.0, 6.0),
        "ml_norm_g": 1.0 + nrm(ks[14], (DEPTH, ML_DV), 0.02),
        "w_branch": nrm(ks[15], (DEPTH, N_BRANCH, BRANCH_W, D_MODEL), BRANCH_W ** -0.5),
        "w_out": nrm(ks[16], (DEPTH, D_MODEL, D_MODEL), D_MODEL ** -0.5),
    }


def reference(x, norm_g, w_in, conv_a, dn_a_log, dn_dt_bias, dn_norm_g, na_q_norm, na_k_norm, na_rpb,
              ga_q_norm, ga_k_norm, ml_i_bias, ml_f_bias, ml_norm_g, w_branch, w_out):
    B, S, _ = x.shape
    rope = _rope_tables(S, x.dtype)
    for l in range(DEPTH):
        h = _rms(x, norm_g[l])
        p = jnp.einsum('bsd,de->bse', h, w_in[l])
        (a_qkv, a_a, a_b, a_z, b_qkv, b_z, c_q, c_k, c_v, c_z,
         d_q, d_k, d_v, d_i, d_f, d_o, d_z, gate_logits) = _split(p, PROJ_SIZES)
        y_a = _mixer_deltanet(a_qkv, a_a, a_b, a_z, conv_a[l], dn_a_log[l], dn_dt_bias[l], dn_norm_g[l])
        y_b = _mixer_natten(b_qkv, b_z, na_q_norm[l], na_k_norm[l], na_rpb[l])
        y_c = _mixer_gqa(c_q, c_k, c_v, c_z, ga_q_norm[l], ga_k_norm[l], rope)
        y_d = _mixer_mlstm(d_q, d_k, d_v, d_i, d_f, d_o, d_z, ml_i_bias[l], ml_f_bias[l], ml_norm_g[l])
        ys = jnp.stack([y_a, y_b, y_c, y_d], axis=2)
        proj = jnp.einsum('bsnw,nwd->bsnd', ys, w_branch[l])
        gates = jax.nn.sigmoid(gate_logits.reshape(B, S, N_BRANCH, D_MODEL))
        merged = jnp.sum(gates * proj, axis=2)
        x = x + jnp.einsum('bsd,de->bse', merged, w_out[l])
    return x
```

```cpp
#include <hip/hip_runtime.h>
#include <hip/hip_cooperative_groups.h>
namespace cg = cooperative_groups;

typedef unsigned short u16;
using bf16x8 = __attribute__((ext_vector_type(8))) short;
using f32x4 = __attribute__((ext_vector_type(4))) float;
using u32x4 = __attribute__((ext_vector_type(4))) unsigned;
using u32x2 = __attribute__((ext_vector_type(2))) unsigned;

constexpr int D = 1024, SEQ = 2048, BATCH = 16, DEPTH = 2, PROJW = 11808;
constexpr int NPASS = 2, BP = BATCH / NPASS, TH = BP * SEQ;
constexpr int NW1 = 7808;
constexpr int NWIN = NW1 + 4096;
constexpr float EPS = 1e-6f;
constexpr int NCHK = BP * 4 * 32;
constexpr size_t LDS_BYTES = 73728;

struct Params {
  const float* x; const float* norm_g; const float* w_in; const float* conv_a; const float* dn_a_log;
  const float* dn_dt_bias; const float* dn_norm_g; const float* na_q_norm; const float* na_k_norm;
  const float* na_rpb; const float* ga_q_norm; const float* ga_k_norm; const float* ml_i_bias;
  const float* ml_f_bias; const float* ml_norm_g; const float* w_branch; const float* w_out;
  float* out;
  u16* WinT; u16* WbT; u16* WoT;
  u16* hbuf; u16* Aqkv; u16* Bqkv; u16* Cqkv; u16* Dqkv; u16* Z; float* Sm; u16* qkvc;
  u16* TP; u16* KdT; float* vecs; u16* MLhb; u16* Bo; u16* Co; u16* VtB; u16* VtC; int* ctr; unsigned* bar; int use_cg; int pad;
};

#define LAS __attribute__((address_space(3)))
__shared__ uint4 g_xb_words;

typedef float f32x2_t __attribute__((ext_vector_type(2)));
typedef __bf16 bf16x2_t __attribute__((ext_vector_type(2)));
__device__ __forceinline__ unsigned pack2(float a, float b) {
  f32x2_t v = {a, b};
  return __builtin_bit_cast(unsigned, __builtin_convertvector(v, bf16x2_t));
}
__device__ __forceinline__ u16 f2bf(float f) { return __builtin_bit_cast(u16, (__bf16)f); }
__device__ __forceinline__ float bf2f(u16 h) { return __uint_as_float(((unsigned)h) << 16); }
__device__ __forceinline__ float wave_sum(float v) {
#pragma unroll
  for (int o = 32; o >= 1; o >>= 1) v += __shfl_xor(v, o);
  return v;
}
__device__ __forceinline__ float grp16_sum(float v) {
#pragma unroll
  for (int o = 8; o >= 1; o >>= 1) v += __shfl_xor(v, o);
  return v;
}
__device__ __forceinline__ float grp16_max(float v) {
#pragma unroll
  for (int o = 8; o >= 1; o >>= 1) v = fmaxf(v, __shfl_xor(v, o));
  return v;
}
__device__ __forceinline__ float sigmoidf_(float x) { return 1.f / (1.f + __expf(-x)); }
__device__ __forceinline__ float siluf_(float x) { return x / (1.f + __expf(-x)); }
__device__ __forceinline__ float softplusf_(float x) { return x > 20.f ? x : __logf(1.f + __expf(x)); }
__device__ __forceinline__ float logsigmoidf_(float x) { return fminf(x, 0.f) - __logf(1.f + __expf(-fabsf(x))); }
__device__ __forceinline__ int otid() {
  int t = threadIdx.x;
  asm volatile("" : "+v"(t));
  return t;
}
#define MFMA(a, b, c) __builtin_amdgcn_mfma_f32_16x16x32_bf16(a, b, c, 0, 0, 0)
__device__ __forceinline__ bf16x8 ldfrag(const u16* p) { return *reinterpret_cast<const bf16x8*>(p); }

__device__ __forceinline__ int win_src_col(int r) {
  if (r < 1536) return r;
  if (r < 3072) return 2064 + (r - 1536);
  if (r < 4096) return 4112 + (r - 3072);
  if (r < 5120) return 5648 + (r - 4096);
  if (r < 5632) return 1552 + (r - 5120);
  if (r < 6144) return 3600 + (r - 5632);
  if (r < 6656) return 5136 + (r - 6144);
  if (r < 7168) return 7200 + (r - 6656);
  if (r < 7680) return 6688 + (r - 7168);
  if (r < 7696) return 1536 + (r - 7680);
  if (r < 7712) return 6672 + (r - 7696);
  if (r < 7808) return -1;
  return 7712 + (r - 7808);
}
__device__ __forceinline__ void tr_tile(const float* __restrict__ src, int ldsrc, u16* __restrict__ dst, int K, int r0, int k0,
                        int mode, float* tile) {
  const int tid = otid();
  {
    int rr = tid & 63, kq = tid >> 6;
    int col = mode ? win_src_col(r0 + rr) : (r0 + rr);
    float v[16];
#pragma unroll
    for (int i = 0; i < 16; i++) v[i] = col >= 0 ? src[(size_t)(k0 + kq + 4 * i) * ldsrc + col] : 0.f;
#pragma unroll
    for (int i = 0; i < 16; i++) tile[(kq + 4 * i) * 65 + rr] = v[i];
  }
  __syncthreads();
  {
    int k2 = (tid & 31) * 2, rq = tid >> 5;
#pragma unroll
    for (int i = 0; i < 8; i++) {
      int r2 = rq + 8 * i;
      *(unsigned*)(dst + (size_t)(r0 + r2) * K + k0 + k2) = pack2(tile[k2 * 65 + r2], tile[(k2 + 1) * 65 + r2]);
    }
  }
  __syncthreads();
}
__device__ __forceinline__ void phase_W(const Params& p, char* smem) {
  float* tile = (float*)smem;
  constexpr int J_IN = (NWIN / 64) * 16, J_B = 4 * 16 * 8, J_O = 16 * 16, J_L = J_IN + J_B + J_O;
  for (int job = blockIdx.x; job < DEPTH * J_L; job += gridDim.x) {
    int l = job / J_L, j = job % J_L;
    if (j < J_IN) {
      int rt = j / 16, kt = j % 16;
      tr_tile(p.w_in + (size_t)l * D * PROJW, PROJW, p.WinT + (size_t)l * NWIN * D, D, rt * 64, kt * 64, 1, tile);
    } else if (j < J_IN + J_B) {
      j -= J_IN;
      int n = j / 128, q = j % 128, rt = q / 8, kt = q % 8;
      tr_tile(p.w_branch + ((size_t)l * 4 + n) * 512 * D, D, p.WbT + ((size_t)l * 4 + n) * D * 512, 512, rt * 64,
              kt * 64, 0, tile);
    } else {
      j -= J_IN + J_B;
      int rt = j / 16, kt = j % 16;
      tr_tile(p.w_out + (size_t)l * D * D, D, p.WoT + (size_t)l * D * D, D, rt * 64, kt * 64, 0, tile);
    }
  }
}

__device__ __forceinline__ void phase_R(const float* __restrict__ xin, const float* __restrict__ g, u16* __restrict__ hbuf) {
  const int tid_ = otid(), lane = tid_ & 63, gw = blockIdx.x * 4 + (tid_ >> 6), nw = gridDim.x * 4;
  for (int t = gw; t < TH; t += nw) {
    const float4* xr = (const float4*)(xin + (size_t)t * D);
    float4 v[4];
    float ss = 0.f;
#pragma unroll
    for (int i = 0; i < 4; i++) {
      v[i] = xr[i * 64 + lane];
      ss += v[i].x * v[i].x + v[i].y * v[i].y + v[i].z * v[i].z + v[i].w * v[i].w;
    }
    ss = wave_sum(ss);
    float sc = rsqrtf(ss * (1.f / D) + EPS);
#pragma unroll
    for (int i = 0; i < 4; i++) {
      float4 gg = ((const float4*)g)[i * 64 + lane];
      u32x2 o;
      o.x = pack2(v[i].x * sc * gg.x, v[i].y * sc * gg.y);
      o.y = pack2(v[i].z * sc * gg.z, v[i].w * sc * gg.w);
      *(u32x2*)(hbuf + (size_t)t * D + (i * 64 + lane) * 4) = o;
    }
  }
}

constexpr int LDSK = 72;
template <int NW>
__device__ __forceinline__ void gemm128(f32x4 (&acc)[4][NW], const u16* __restrict__ A, int lda,
                                        const u16* __restrict__ Bt, int ldb, int K, u16* sA, u16* sB) {
  const int tid = otid(), lane = tid & 63, w = tid >> 6, wm = w >> 1, wn = w & 1, fr = lane & 15, fq = lane >> 4;
  u32x4 ra[4], rb[NW];
#pragma unroll
  for (int i = 0; i < 4; i++) {
    int c = tid + i * 256, row = c >> 3, kc = c & 7;
    ra[i] = *(const u32x4*)(A + (size_t)row * lda + kc * 8);
    if (i < NW) rb[i] = *(const u32x4*)(Bt + (size_t)row * ldb + kc * 8);
  }
  for (int k0 = 0; k0 < K; k0 += 64) {
#pragma unroll
    for (int i = 0; i < 4; i++) {
      int c = tid + i * 256, row = c >> 3, kc = c & 7;
      *(u32x4*)(sA + row * LDSK + kc * 8) = ra[i];
      if (i < NW) *(u32x4*)(sB + row * LDSK + kc * 8) = rb[i];
    }
    __syncthreads();
    if (k0 + 64 < K) {
#pragma unroll
      for (int i = 0; i < 4; i++) {
        int c = tid + i * 256, row = c >> 3, kc = c & 7;
        ra[i] = *(const u32x4*)(A + (size_t)row * lda + k0 + 64 + kc * 8);
        if (i < NW) rb[i] = *(const u32x4*)(Bt + (size_t)row * ldb + k0 + 64 + kc * 8);
      }
    }
#pragma unroll
    for (int ks = 0; ks < 2; ks++) {
      bf16x8 af[4], bfr[NW];
#pragma unroll
      for (int m = 0; m < 4; m++) af[m] = ldfrag(sA + (wm * 64 + m * 16 + fr) * LDSK + ks * 32 + fq * 8);
#pragma unroll
      for (int n = 0; n < NW; n++) bfr[n] = ldfrag(sB + (wn * 16 * NW + n * 16 + fr) * LDSK + ks * 32 + fq * 8);
#pragma unroll
      for (int m = 0; m < 4; m++)
#pragma unroll
        for (int n = 0; n < NW; n++) acc[m][n] = MFMA(af[m], bfr[n], acc[m][n]);
    }
    __syncthreads();
  }
}
#define ZERO_ACC(a, NWV)                                                                                  \
  _Pragma("unroll") for (int m_ = 0; m_ < 4; m_++) _Pragma("unroll") for (int n_ = 0; n_ < NWV; n_++) a[m_][n_] = \
      f32x4{0.f, 0.f, 0.f, 0.f};

__device__ __forceinline__ int swz1k(int ob) { return ob ^ (((ob >> 9) & 1) << 5); }
template <int MW, int NW, bool SWAP = false>
__device__ __forceinline__ void gemm_dma(f32x4 (&acc)[MW][NW], const u16* __restrict__ A, int lda,
                                         const u16* __restrict__ Bt, int ldb, int K, char* smem) {
  constexpr int BM = 32 * MW, BN = 32 * NW, STG = (BM + BN) * 64, NLA = BM / 64, NLB = BN / 64, NL = NLA + NLB;
  const int tid = otid(), lane = tid & 63, w = tid >> 6, wm = w >> 1, wn = w & 1, fr = lane & 15, fq = lane >> 4;
  int offA[NLA], offB[NLB];
#pragma unroll
  for (int i = 0; i < NLA; i++) {
    int b = (tid + i * 256) * 16, st = b >> 10, sw = swz1k(b & 1023);
    offA[i] = (st * 16 + (sw >> 6)) * lda + ((sw & 63) >> 1);
  }
#pragma unroll
  for (int i = 0; i < NLB; i++) {
    int b = (tid + i * 256) * 16, st = b >> 10, sw = swz1k(b & 1023);
    offB[i] = (st * 16 + (sw >> 6)) * ldb + ((sw & 63) >> 1);
  }
  const int fo = swz1k(fr * 64 + fq * 16);
  const int nk = K >> 5;
  auto issue = [&](int t) {
    char* stg = smem + (t % 3) * STG;
#pragma unroll
    for (int i = 0; i < NLA; i++)
      __builtin_amdgcn_global_load_lds((const unsigned*)(A + offA[i] + t * 32), (unsigned*)(stg + (tid + i * 256) * 16), 16, 0,
                                       0);
#pragma unroll
    for (int i = 0; i < NLB; i++)
      __builtin_amdgcn_global_load_lds((const unsigned*)(Bt + offB[i] + t * 32),
                                       (unsigned*)(stg + BM * 64 + (tid + i * 256) * 16), 16, 0, 0);
  };
  issue(0);
  if (nk > 1) issue(1);
  for (int t = 0; t < nk; t++) {
    if (t + 1 < nk) asm volatile("s_waitcnt vmcnt(%0)" ::"n"(NL) : "memory");
    else asm volatile("s_waitcnt vmcnt(0)" ::: "memory");
    __builtin_amdgcn_s_barrier();
    const char* stg = smem + (t % 3) * STG;
    bf16x8 af[MW], bfr[NW];
#pragma unroll
    for (int m = 0; m < MW; m++) af[m] = *(const bf16x8*)(stg + (wm * MW + m) * 1024 + fo);
#pragma unroll
    for (int n = 0; n < NW; n++) bfr[n] = *(const bf16x8*)(stg + BM * 64 + (wn * NW + n) * 1024 + fo);
    if (t + 2 < nk) issue(t + 2);
    __builtin_amdgcn_s_setprio(1);
#pragma unroll
    for (int m = 0; m < MW; m++)
#pragma unroll
      for (int n = 0; n < NW; n++) acc[m][n] = SWAP ? MFMA(bfr[n], af[m], acc[m][n]) : MFMA(af[m], bfr[n], acc[m][n]);
    __builtin_amdgcn_s_setprio(0);
  }
  __builtin_amdgcn_s_barrier();
}
#define ZERO_ACC2(a, MWV, NWV)                                                                              \
  _Pragma("unroll") for (int m_ = 0; m_ < MWV; m_++) _Pragma("unroll") for (int n_ = 0; n_ < NWV; n_++) a[m_][n_] = \
      f32x4{0.f, 0.f, 0.f, 0.f};
__device__ __forceinline__ void tile_of(int id, int ntiles, int NT, int& mt, int& nt) {
  int q = (id & 7) * (ntiles >> 3) + (id >> 3);
  mt = (q / (NT * 8)) * 8 + (q & 7);
  nt = (q >> 3) % NT;
}

__device__ __forceinline__ void phase_G1(const Params& p, int l, char* smem) {
  const int tid = otid(), lane = tid & 63, w = tid >> 6, wm = w >> 1, wn = w & 1, fr = lane & 15, fq = lane >> 4;
  constexpr int NT = NW1 / 128, MTL = TH / 256;
  const u16* W = p.WinT + (size_t)l * NWIN * D;
  for (int id = blockIdx.x; id < NT * MTL; id += gridDim.x) {
    int mt, nt;
    tile_of(id, NT * MTL, NT, mt, nt);
    int n0 = nt * 128;
    u16* dst;
    int ldd, cb, act = 0, mode = 0;
    if (n0 < 1536) { dst = p.Aqkv; ldd = 1536; cb = n0; }
    else if (n0 < 3072) { dst = p.Bqkv; ldd = 1024; cb = n0 - 1536; mode = (cb < 1024) ? 1 : 3; }
    else if (n0 < 4096) { dst = p.Cqkv; ldd = 768; cb = n0 - 3072; mode = (cb < 768) ? 2 : 4; }
    else if (n0 < 5120) { dst = p.Dqkv; ldd = 1024; cb = n0 - 4096; }
    else if (n0 < 7680) { dst = p.Z; ldd = 2560; cb = n0 - 5120; act = (cb < 2048) ? 1 : 2; }
    else { dst = nullptr; ldd = 0; cb = 0; }
    f32x4 acc[8][4];
    ZERO_ACC2(acc, 8, 4);
    if (mode == 0) gemm_dma<8, 4, true>(acc, p.hbuf + (size_t)mt * 256 * D, D, W + (size_t)nt * 128 * D, D, D, smem);
    else gemm_dma<8, 4, false>(acc, p.hbuf + (size_t)mt * 256 * D, D, W + (size_t)nt * 128 * D, D, D, smem);
    if (mode == 1) {
      const int te = otid(), fr = te & 15, fq = (te >> 4) & 3, wm = te >> 7, wn = (te >> 6) & 1;
      const float* g = (cb < 512 ? p.na_q_norm : p.na_k_norm) + l * 64;
      float gv[4];
      const float qs = (cb < 512) ? 0.125f * 1.4426950408889634f : 1.f;
#pragma unroll
      for (int n = 0; n < 4; n++) gv[n] = g[n * 16 + fr] * qs;
#pragma unroll
      for (int m = 0; m < 8; m++)
#pragma unroll
        for (int j = 0; j < 4; j++) {
          float ss = 0.f;
#pragma unroll
          for (int n = 0; n < 4; n++) ss += acc[m][n][j] * acc[m][n][j];
          ss = grp16_sum(ss);
          float sc = rsqrtf(ss * (1.f / 64.f) + EPS);
          int row = mt * 256 + wm * 128 + m * 16 + fq * 4 + j;
#pragma unroll
          for (int n = 0; n < 4; n++)
            dst[(size_t)row * ldd + cb + wn * 64 + n * 16 + fr] = f2bf(acc[m][n][j] * sc * gv[n]);
        }
    } else if (mode == 2) {
      float* sX = (float*)smem;
      const int te = otid(), fr = te & 15, fq = (te >> 4) & 3, wm = te >> 7, wn = (te >> 6) & 1;
      const float* g = (cb < 512 ? p.ga_q_norm : p.ga_k_norm) + l * 128 + wn * 64;
      float gv[4];
      const float qs = (cb < 512) ? 0.08838834764831845f * 1.4426950408889634f : 1.f;
#pragma unroll
      for (int n = 0; n < 4; n++) gv[n] = g[n * 16 + fr] * qs;
#pragma unroll
      for (int m = 0; m < 8; m++)
#pragma unroll
        for (int j = 0; j < 4; j++) {
          float ss = 0.f;
#pragma unroll
          for (int n = 0; n < 4; n++) ss += acc[m][n][j] * acc[m][n][j];
          ss = grp16_sum(ss);
          if (fr == 0) sX[(wm * 128 + m * 16 + fq * 4 + j) * 2 + wn] = ss;
        }
      __syncthreads();
      float inv[2];
#pragma unroll
      for (int n = 0; n < 2; n++) inv[n] = exp2f(-(float)(n * 16 + fr) * (13.287712379549449f / 32.f));
#pragma unroll
      for (int m = 0; m < 8; m++)
#pragma unroll
        for (int j = 0; j < 4; j++) {
          int rl = wm * 128 + m * 16 + fq * 4 + j, row = mt * 256 + rl;
          float sc = rsqrtf((sX[rl * 2] + sX[rl * 2 + 1]) * (1.f / 128.f) + EPS);
          int ts = row & (SEQ - 1);
          float pos = wn ? (float)(ts & 63) : (float)(ts >> 6);
#pragma unroll
          for (int n = 0; n < 2; n++) {
            float ang = pos * inv[n];
            float kf = rintf(ang * 0.15915494309189535f);
            float rr = fmaf(-kf, 6.2831855f, ang);
            rr = fmaf(-kf, -1.7484555e-7f, rr);
            float sn = __sinf(rr), cs = __cosf(rr);
            float y1 = acc[m][n][j] * sc * gv[n], y2 = acc[m][n + 2][j] * sc * gv[n + 2];
            u16* o = dst + (size_t)row * ldd + cb + wn * 64 + n * 16 + fr;
            o[0] = f2bf(y1 * cs - y2 * sn);
            o[32] = f2bf(y1 * sn + y2 * cs);
          }
          __builtin_amdgcn_sched_barrier(0);
        }
      __syncthreads();
    } else if (mode >= 3) {
      const int te = otid(), fr = te & 15, fq = (te >> 4) & 3, wm = te >> 7, wn = (te >> 6) & 1;
      const int row0 = mt * 256 + wm * 128, bl = row0 >> 11;
      u16* vt;
      if (mode == 3) vt = p.VtB + ((size_t)(bl * 8 + ((cb - 1024) >> 6) + wn) * 64) * SEQ;
      else vt = p.VtC + ((size_t)(bl * 2 + ((cb - 768) >> 7)) * 128 + wn * 64) * SEQ;
#pragma unroll
      for (int m = 0; m < 8; m++)
#pragma unroll
        for (int n = 0; n < 4; n++) {
          u32x2 o;
          o.x = pack2(acc[m][n][0], acc[m][n][1]);
          o.y = pack2(acc[m][n][2], acc[m][n][3]);
          *(u32x2*)(vt + (size_t)(n * 16 + fr) * SEQ + ((row0 + m * 16 + fq * 4) & (SEQ - 1))) = o;
        }
    } else {
      const int te = otid(), fr = te & 15, fq = (te >> 4) & 3, wm = te >> 7, wn = (te >> 6) & 1;
#pragma unroll
      for (int m = 0; m < 8; m++)
#pragma unroll
        for (int n = 0; n < 4; n++) {
          const int row = mt * 256 + wm * 128 + m * 16 + fr, col0 = wn * 64 + n * 16 + fq * 4;
          f32x4 v = acc[m][n];
          if (dst) {
            if (act == 1) { v[0] = siluf_(v[0]); v[1] = siluf_(v[1]); v[2] = siluf_(v[2]); v[3] = siluf_(v[3]); }
            else if (act == 2) { v[0] = sigmoidf_(v[0]); v[1] = sigmoidf_(v[1]); v[2] = sigmoidf_(v[2]); v[3] = sigmoidf_(v[3]); }
            u32x2 o;
            o.x = pack2(v[0], v[1]);
            o.y = pack2(v[2], v[3]);
            *(u32x2*)(dst + (size_t)row * ldd + cb + col0) = o;
          } else if (col0 < 32) {
            *(f32x4*)(p.Sm + (size_t)row * 32 + col0) = v;
          }
        }
    }
  }
}

__device__ __forceinline__ void dn_prep_item(const Params& p, int l, int item, char* smem) {
  const int tid = otid(), lane = tid & 63, w = tid >> 6, fr = lane & 15, fq = lane >> 4;
  const int c = item & 31, h = (item >> 5) & 3, bl = item >> 7;
  u16* sQ = (u16*)smem;
  u16* sK = sQ + 64 * 136;
  float* sAm = (float*)(sK + 64 * 136);
  float* sBeta = sAm + 2 * 64 * 68;
  float* sGc = sBeta + 128;
  const size_t tbase = (size_t)bl * SEQ;
  const int t0 = c * 64;
  for (int part = 0; part < 3; part++) {
    const int ch = part * 512 + h * 128 + 2 * lane;
    float w0[5], w1[5];
#pragma unroll
    for (int j = 0; j < 5; j++) {
      w0[j] = p.conv_a[((size_t)l * 5 + j) * 1536 + ch];
      w1[j] = p.conv_a[((size_t)l * 5 + j) * 1536 + ch + 1];
    }
    const int rs = t0 + w * 16;
    unsigned xin[20];
#pragma unroll
    for (int r = 0; r < 20; r++) {
      int t = rs - 2 + r;
      xin[r] = (t >= 0 && t < SEQ) ? *(const unsigned*)(p.Aqkv + (tbase + t) * 1536 + ch) : 0u;
    }
    float y0[16], y1[16];
#pragma unroll
    for (int rr = 0; rr < 16; rr++) {
      float a0 = 0.f, a1 = 0.f;
#pragma unroll
      for (int j = 0; j < 5; j++) {
        a0 += w0[j] * bf2f((u16)(xin[rr + j] & 0xffff));
        a1 += w1[j] * bf2f((u16)(xin[rr + j] >> 16));
      }
      y0[rr] = siluf_(a0);
      y1[rr] = siluf_(a1);
    }
    if (part < 2) {
      float ss[16];
#pragma unroll
      for (int rr = 0; rr < 16; rr++) ss[rr] = y0[rr] * y0[rr] + y1[rr] * y1[rr];
#pragma unroll
      for (int o = 32; o >= 1; o >>= 1)
#pragma unroll
        for (int rr = 0; rr < 16; rr++) ss[rr] += __shfl_xor(ss[rr], o);
#pragma unroll
      for (int rr = 0; rr < 16; rr++) {
        float sc = rsqrtf(ss[rr] + EPS) * (part == 0 ? 0.08838834764831845f : 1.f);
        unsigned pk = pack2(y0[rr] * sc, y1[rr] * sc);
        *(unsigned*)((part == 0 ? sQ : sK) + (w * 16 + rr) * 136 + 2 * lane) = pk;
        *(unsigned*)(p.qkvc + (tbase + rs + rr) * 1536 + ch) = pk;
      }
    } else {
#pragma unroll
      for (int rr = 0; rr < 16; rr++) *(unsigned*)(p.qkvc + (tbase + rs + rr) * 1536 + ch) = pack2(y0[rr], y1[rr]);
    }
  }
  if (w < 2) {
    const int d = w, ip = lane;
    const int t = t0 + (d ? 63 - ip : ip);
    float apre = p.Sm[(tbase + t) * 32 + d * 4 + h];
    float bpre = p.Sm[(tbase + t) * 32 + 8 + d * 4 + h];
    float g = -__expf(p.dn_a_log[l * 8 + d * 4 + h]) * softplusf_(apre + p.dn_dt_bias[l * 8 + d * 4 + h]);
    float beta = 1.f / (1.f + __expf(-bpre));
    float gc = g;
#pragma unroll
    for (int off = 1; off < 64; off <<= 1) {
      float v = __shfl_up(gc, off);
      if (lane >= off) gc += v;
    }
    sBeta[d * 64 + ip] = beta;
    sGc[d * 64 + ip] = gc;
  }
  __syncthreads();
  {
    f32x4 akk[4], aqk[4];
#pragma unroll
    for (int n = 0; n < 4; n++) { akk[n] = f32x4{0, 0, 0, 0}; aqk[n] = f32x4{0, 0, 0, 0}; }
#pragma unroll
    for (int ks = 0; ks < 4; ks++) {
      bf16x8 fk = ldfrag(sK + (16 * w + fr) * 136 + ks * 32 + fq * 8);
      bf16x8 fqv = ldfrag(sQ + (16 * w + fr) * 136 + ks * 32 + fq * 8);
#pragma unroll
      for (int n = 0; n < 4; n++) {
        bf16x8 fb = ldfrag(sK + (n * 16 + fr) * 136 + ks * 32 + fq * 8);
        akk[n] = MFMA(fk, fb, akk[n]);
        aqk[n] = MFMA(fqv, fb, aqk[n]);
      }
    }
#pragma unroll
    for (int d = 0; d < 2; d++) {
      u16* Pg = p.TP + ((size_t)(item * 2 + d) * 2 + 1) * 4096;
#pragma unroll
      for (int n = 0; n < 4; n++)
#pragma unroll
        for (int j = 0; j < 4; j++) {
          int i = 16 * w + fq * 4 + j, jj = n * 16 + fr;
          int ip = d ? 63 - i : i, jp = d ? 63 - jj : jj;
          float e = (jp <= ip) ? __expf(sGc[d * 64 + ip] - sGc[d * 64 + jp]) : 0.f;
          float av = (jp < ip) ? sBeta[d * 64 + ip] * akk[n][j] * e : 0.f;
          sAm[(d * 64 + ip) * 68 + jp] = av;
          Pg[ip * 64 + jp] = f2bf(aqk[n][j] * e);
        }
    }
  }
  __syncthreads();
  {
#pragma unroll
    for (int d = 0; d < 2; d++) {
      int jp = lane, j = d ? 63 - jp : jp;
      float e = __expf(sGc[d * 64 + 63] - sGc[d * 64 + jp]);
      u16* Kg = p.KdT + (size_t)(item * 2 + d) * 8192;
#pragma unroll
      for (int c8 = 0; c8 < 4; c8++) {
        const int dk0 = w * 32 + c8 * 8;
        u32x4 kv = *(const u32x4*)(sK + j * 136 + dk0);
#pragma unroll
        for (int e2 = 0; e2 < 4; e2++) {
          Kg[(dk0 + 2 * e2) * 64 + jp] = f2bf(bf2f((u16)(kv[e2] & 0xffff)) * e);
          Kg[(dk0 + 2 * e2 + 1) * 64 + jp] = f2bf(bf2f((u16)(kv[e2] >> 16)) * e);
        }
      }
    }
    if (w >= 2) {
      int d = w - 2;
      float* vb = p.vecs + (size_t)(item * 2 + d) * 144;
      vb[lane] = sBeta[d * 64 + lane];
      vb[64 + lane] = __expf(sGc[d * 64 + lane]);
      if (lane == 0) vb[128] = __expf(sGc[d * 64 + 63]);
    }
  }
  if (w < 2) {
    const int d = w;
    const float* Am = sAm + d * 64 * 68;
    int cc = lane;
    asm volatile("" : "+v"(cc));
    float x[64];
#pragma unroll
    for (int i = 0; i < 64; i++) {
      float s = (i == cc) ? 1.f : 0.f;
#pragma unroll
      for (int j = 0; j < i; j++) s -= Am[i * 68 + j] * x[j];
      x[i] = s;
      __builtin_amdgcn_sched_barrier(0);
    }
    u16* Tg = p.TP + ((size_t)(item * 2 + d) * 2 + 0) * 4096;
#pragma unroll
    for (int i = 0; i < 64; i++) Tg[i * 64 + cc] = f2bf(x[i]);
  }
  __syncthreads();
}

__device__ __forceinline__ void phase_P2(const Params& p, int l, char* smem) {
  for (int item = blockIdx.x; item < NCHK; item += gridDim.x) dn_prep_item(p, l, item, smem);
}

__device__ __forceinline__ void lds_barrier() { asm volatile("s_waitcnt lgkmcnt(0)\n\ts_barrier" ::: "memory"); }
struct DnStep {
  bf16x8 ka[4], ta[2];
  float v[2][4], beta[4], egc[4], gtot;
};
struct DnLate {
  bf16x8 qa[4], pa[2], kd[2][2];
};
__device__ __forceinline__ void dn_load(DnStep& s, const Params& p, int bl, int h, int d, int sl, int cn, int w,
                                        int fr, int fq) {
  const int c = d ? 31 - cn : cn;
  const int pd = (((bl * 4 + h) * 32 + c) * 2 + d);
  const u16* Tg = p.TP + (size_t)pd * 8192;
  const float* vb = p.vecs + (size_t)pd * 144;
  const size_t tb = (size_t)bl * SEQ + c * 64;
  const int ipA = 16 * w + fr;
  const u16* krow = p.qkvc + (tb + (d ? 63 - ipA : ipA)) * 1536 + 512 + h * 128;
#pragma unroll
  for (int ks = 0; ks < 4; ks++) s.ka[ks] = ldfrag(krow + ks * 32 + fq * 8);
#pragma unroll
  for (int ks = 0; ks < 2; ks++) s.ta[ks] = ldfrag(Tg + (16 * w + fr) * 64 + ks * 32 + fq * 8);
#pragma unroll
  for (int j = 0; j < 4; j++) {
    int ip = 16 * w + fq * 4 + j;
    s.beta[j] = vb[ip];
    s.egc[j] = vb[64 + ip];
    size_t t = tb + (d ? 63 - ip : ip);
#pragma unroll
    for (int n = 0; n < 2; n++) s.v[n][j] = bf2f(p.qkvc[t * 1536 + 1024 + h * 128 + sl * 32 + n * 16 + fr]);
  }
  s.gtot = vb[128];
}
__device__ __forceinline__ void dn_load_q(DnLate& s, const Params& p, int bl, int h, int d, int cn, int w, int fr,
                                          int fq) {
  const int c = d ? 31 - cn : cn;
  const size_t tb = (size_t)bl * SEQ + c * 64;
  const int ipA = 16 * w + fr;
  const u16* qrow = p.qkvc + (tb + (d ? 63 - ipA : ipA)) * 1536 + h * 128;
#pragma unroll
  for (int ks = 0; ks < 4; ks++) s.qa[ks] = ldfrag(qrow + ks * 32 + fq * 8);
}
__device__ __forceinline__ void dn_load_pk(DnLate& s, const Params& p, int bl, int h, int d, int cn, int w, int fr,
                                           int fq) {
  const int c = d ? 31 - cn : cn;
  const int pd = (((bl * 4 + h) * 32 + c) * 2 + d);
  const u16* Pg = p.TP + (size_t)pd * 8192 + 4096;
  const u16* Kg = p.KdT + (size_t)pd * 8192;
#pragma unroll
  for (int ks = 0; ks < 2; ks++) {
    s.pa[ks] = ldfrag(Pg + (16 * w + fr) * 64 + ks * 32 + fq * 8);
#pragma unroll
    for (int m = 0; m < 2; m++) s.kd[m][ks] = ldfrag(Kg + (32 * w + m * 16 + fr) * 64 + ks * 32 + fq * 8);
  }
}
__device__ __forceinline__ void dn_step(const Params& p, int bl, const DnStep& cur, DnLate& lt, f32x4 (&Sacc)[2][2],
                                        u16* sST, u16* sRT, u16* sVnT, u16* og, size_t tbase, int cn, int d, int h,
                                        int sl, int w, int fr, int fq) {
  const int c = d ? 31 - cn : cn;
  const int cb = c * 64;
  const int cnn = cn + 1 < 32 ? cn + 1 : 31;
#pragma unroll
  for (int m = 0; m < 2; m++)
#pragma unroll
    for (int n = 0; n < 2; n++) {
      u32x2 o;
      o.x = pack2(Sacc[m][n][0], Sacc[m][n][1]);
      o.y = pack2(Sacc[m][n][2], Sacc[m][n][3]);
      *(u32x2*)(sST + (n * 16 + fr) * 136 + 32 * w + m * 16 + fq * 4) = o;
    }
  lds_barrier();
  f32x4 kS[2];
  kS[0] = kS[1] = f32x4{0, 0, 0, 0};
#pragma unroll
  for (int ks = 0; ks < 4; ks++) {
#pragma unroll
    for (int n = 0; n < 2; n++) kS[n] = MFMA(cur.ka[ks], ldfrag(sST + (n * 16 + fr) * 136 + ks * 32 + fq * 8), kS[n]);
  }
#pragma unroll
  for (int n = 0; n < 2; n++) {
    float r[4];
#pragma unroll
    for (int j = 0; j < 4; j++) r[j] = cur.beta[j] * (cur.v[n][j] - cur.egc[j] * kS[n][j]);
    u32x2 o;
    o.x = pack2(r[0], r[1]);
    o.y = pack2(r[2], r[3]);
    *(u32x2*)(sRT + (n * 16 + fr) * 72 + 16 * w + fq * 4) = o;
  }
  lds_barrier();
  f32x4 vn[2];
  vn[0] = vn[1] = f32x4{0, 0, 0, 0};
#pragma unroll
  for (int ks = 0; ks < 2; ks++)
#pragma unroll
    for (int n = 0; n < 2; n++) vn[n] = MFMA(cur.ta[ks], ldfrag(sRT + (n * 16 + fr) * 72 + ks * 32 + fq * 8), vn[n]);
  f32x4 qS[2];
  qS[0] = qS[1] = f32x4{0, 0, 0, 0};
#pragma unroll
  for (int ks = 0; ks < 4; ks++) {
#pragma unroll
    for (int n = 0; n < 2; n++) qS[n] = MFMA(lt.qa[ks], ldfrag(sST + (n * 16 + fr) * 136 + ks * 32 + fq * 8), qS[n]);
  }
  dn_load_q(lt, p, bl, h, d, cnn, w, fr, fq);
#pragma unroll
  for (int n = 0; n < 2; n++) {
    u32x2 o;
    o.x = pack2(vn[n][0], vn[n][1]);
    o.y = pack2(vn[n][2], vn[n][3]);
    *(u32x2*)(sVnT + (n * 16 + fr) * 72 + 16 * w + fq * 4) = o;
  }
  lds_barrier();
  f32x4 oo[2];
  oo[0] = oo[1] = f32x4{0, 0, 0, 0};
#pragma unroll
  for (int m = 0; m < 2; m++)
#pragma unroll
    for (int n = 0; n < 2; n++) Sacc[m][n] *= cur.gtot;
#pragma unroll
  for (int ks = 0; ks < 2; ks++) {
    bf16x8 vbf[2];
#pragma unroll
    for (int n = 0; n < 2; n++) vbf[n] = ldfrag(sVnT + (n * 16 + fr) * 72 + ks * 32 + fq * 8);
#pragma unroll
    for (int n = 0; n < 2; n++) oo[n] = MFMA(lt.pa[ks], vbf[n], oo[n]);
#pragma unroll
    for (int m = 0; m < 2; m++)
#pragma unroll
      for (int n = 0; n < 2; n++) Sacc[m][n] = MFMA(lt.kd[m][ks], vbf[n], Sacc[m][n]);
  }
#pragma unroll
  for (int n = 0; n < 2; n++)
#pragma unroll
    for (int j = 0; j < 4; j++) {
      int ip = 16 * w + fq * 4 + j;
      size_t t = tbase + cb + (d ? 63 - ip : ip);
      og[t * 512 + h * 128 + sl * 32 + n * 16 + fr] = f2bf(cur.egc[j] * qS[n][j] + oo[n][j]);
    }
  dn_load_pk(lt, p, bl, h, d, cnn, w, fr, fq);
}
__device__ __forceinline__ void dn_scan_item(const Params& p, int item, char* smem) {
  const int tid = otid(), lane = tid & 63, w = tid >> 6, fr = lane & 15, fq = lane >> 4;
  const int sl = item & 3, d = (item >> 2) & 1, h = (item >> 3) & 3, bl = item >> 5;
  u16* sST = (u16*)smem;
  u16* sRT = sST + 32 * 136;
  u16* sVnT = sRT + 32 * 72;
  const size_t tbase = (size_t)bl * SEQ;
  u16* og = p.Aqkv + (size_t)d * TH * 512;
  f32x4 Sacc[2][2];
#pragma unroll
  for (int m = 0; m < 2; m++)
#pragma unroll
    for (int n = 0; n < 2; n++) Sacc[m][n] = f32x4{0, 0, 0, 0};
  DnStep sa, sb;
  DnLate lt;
  dn_load(sa, p, bl, h, d, sl, 0, w, fr, fq);
  dn_load_q(lt, p, bl, h, d, 0, w, fr, fq);
  dn_load_pk(lt, p, bl, h, d, 0, w, fr, fq);
  __syncthreads();
  for (int cn = 0; cn < 32; cn += 2) {
    dn_load(sb, p, bl, h, d, sl, cn + 1, w, fr, fq);
    dn_step(p, bl, sa, lt, Sacc, sST, sRT, sVnT, og, tbase, cn, d, h, sl, w, fr, fq);
    if (cn + 2 < 32) dn_load(sa, p, bl, h, d, sl, cn + 2, w, fr, fq);
    dn_step(p, bl, sb, lt, Sacc, sST, sRT, sVnT, og, tbase, cn + 1, d, h, sl, w, fr, fq);
  }
  __syncthreads();
}

struct MlStep { u32x4 q[2], k[2], v; };
__device__ __forceinline__ void ml_load(MlStep& s, const Params& p, size_t tbase, int h, int d, int sl, int cn,
                                        int tid) {
  const int c = d ? 31 - cn : cn, cb = c * 64;
#pragma unroll
  for (int i = 0; i < 2; i++) {
    int cidx = tid + i * 256, ip = cidx >> 3, kc = cidx & 7;
    const size_t t = tbase + cb + (d ? 63 - ip : ip);
    s.q[i] = *(const u32x4*)(p.Dqkv + t * 1024 + h * 64 + kc * 8);
    s.k[i] = *(const u32x4*)(p.Dqkv + t * 1024 + 256 + h * 64 + kc * 8);
  }
  {
    int ip = tid >> 2, kc = tid & 3;
    const size_t t = tbase + cb + (d ? 63 - ip : ip);
    s.v = *(const u32x4*)(p.Dqkv + t * 1024 + 512 + h * 128 + sl * 32 + kc * 8);
  }
}
struct MlG { float ipre, fpre; };
__device__ __forceinline__ void ml_gload(MlG& g, const Params& p, size_t tbase, int h, int d, int cn, int lane) {
  const int c = d ? 31 - cn : cn, cb = c * 64, ip = lane;
  const size_t t = tbase + cb + (d ? 63 - ip : ip);
  g.ipre = p.Sm[t * 32 + 16 + d * 4 + h];
  g.fpre = p.Sm[t * 32 + 24 + d * 4 + h];
}
__device__ __forceinline__ void ml_gates(const MlG& g, int lane, float ib, float fb, float* sG) {
  const int ip = lane;
  float ig = g.ipre + ib;
  float lf = logsigmoidf_(g.fpre + fb);
  float b = lf;
#pragma unroll
  for (int off = 1; off < 64; off <<= 1) {
    float v = __shfl_up(b, off);
    if (lane >= off) b += v;
  }
  float a = ig - b;
  float pm = a;
#pragma unroll
  for (int off = 1; off < 64; off <<= 1) {
    float v = __shfl_up(pm, off);
    if (lane >= off) pm = fmaxf(pm, v);
  }
  const float pml = __shfl(pm, 63);
  sG[ip] = a;
  sG[64 + ip] = pm;
  sG[128 + ip] = b;
  sG[192 + ip] = __expf(a - pml);
  sG[256 + ip] = 0.125f * __expf(fminf(pml - pm, 80.f));
}
struct MlCtx {
  u16 *sQ, *sK, *sKT, *sS, *sVT, *sCT;
  float* sGall;
  u16* og;
  size_t tbase;
  float ib, fb;
  int h, d, sl, tid, lane, w, fr, fq, vf;
};
__device__ __forceinline__ void ml_step(const Params& p, const MlStep& cur, const MlG& gnext, f32x4 (&Cacc)[3],
                                        float& m_st, const MlCtx& x, int cn) {
  u16 *sQ = x.sQ, *sK = x.sK, *sKT = x.sKT, *sS = x.sS, *sVT = x.sVT, *sCT = x.sCT;
  float* sGall = x.sGall;
  u16* og = x.og;
  const size_t tbase = x.tbase;
  const float ib = x.ib, fb = x.fb;
  const int h = x.h, d = x.d, sl = x.sl, tid = x.tid, lane = x.lane, w = x.w, fr = x.fr, fq = x.fq;
    const int c = d ? 31 - cn : cn;
  const int cb = c * 64;
  const float* sA = sGall + (cn & 1) * 320;
  const float* sEa = sA + 192;
  const float* sEp = sA + 256;
  const float* sPm = sA + 64;
  const float* sBv = sA + 128;
  const float pm_last = sPm[63], b_last = sBv[63];
#pragma unroll
  for (int i = 0; i < 2; i++) {
    int cidx = tid + i * 256, ip = cidx >> 3, kc = cidx & 7;
    *(u32x4*)(sQ + ip * 72 + kc * 8) = cur.q[i];
    *(u32x4*)(sK + ip * 72 + kc * 8) = cur.k[i];
    u32x4 uk = cur.k[i];
    float wsc = sEa[ip] * 0.125f;
    u16* dst = sKT + (kc * 8) * 72 + ((((ip >> 3) ^ kc) & 7) * 8) + (ip & 7);
#pragma unroll
    for (int e = 0; e < 4; e++) {
      unsigned pk = pack2(bf2f((u16)(uk[e] & 0xffff)) * wsc, __uint_as_float(uk[e] & 0xffff0000u) * wsc);
      dst[(2 * e) * 72] = (u16)(pk & 0xffff);
      dst[(2 * e + 1) * 72] = (u16)(pk >> 16);
    }
  }
  {
    int ip = tid >> 2, kc = tid & 3;
    u32x4 uv = cur.v;
    u16* dst = sVT + (kc * 8) * 72 + ((((ip >> 3) ^ kc) & 7) * 8) + (ip & 7);
#pragma unroll
    for (int e = 0; e < 4; e++) {
      dst[(2 * e) * 72] = (u16)(uv[e] & 0xffff);
      dst[(2 * e + 1) * 72] = (u16)(uv[e] >> 16);
    }
  }
#pragma unroll
  for (int n = 0; n < 3; n++) {
    u32x2 o;
    o.x = pack2(Cacc[n][0], Cacc[n][1]);
    o.y = pack2(Cacc[n][2], Cacc[n][3]);
    *(u32x2*)(sCT + (n * 16 + fr) * 72 + 16 * w + fq * 4) = o;
  }
  lds_barrier();
  if (w == 3 && cn + 1 < 32) ml_gates(gnext, lane, ib, fb, sGall + ((cn + 1) & 1) * 320);
  {
    f32x4 s1[4];
#pragma unroll
    for (int n = 0; n < 4; n++) s1[n] = f32x4{0, 0, 0, 0};
#pragma unroll
    for (int ks = 0; ks < 2; ks++) {
      bf16x8 qa = ldfrag(sQ + (16 * w + fr) * 72 + ks * 32 + fq * 8);
#pragma unroll
      for (int n = 0; n < 4; n++) s1[n] = MFMA(qa, ldfrag(sK + (n * 16 + fr) * 72 + ks * 32 + fq * 8), s1[n]);
    }
    float eaj[4], epi[4];
#pragma unroll
    for (int n = 0; n < 4; n++) eaj[n] = sEa[n * 16 + fr];
#pragma unroll
    for (int j = 0; j < 4; j++) epi[j] = sEp[16 * w + fq * 4 + j];
#pragma unroll
    for (int n = 0; n < 4; n++)
#pragma unroll
      for (int j = 0; j < 4; j++) {
        int i = 16 * w + fq * 4 + j, jj = n * 16 + fr;
        float v = s1[n][j] * eaj[n] * epi[j];
        sS[i * 72 + jj] = f2bf(jj <= i ? v : 0.f);
      }
  }
  lds_barrier();
  f32x4 qC[3], SV[3], dC[3];
#pragma unroll
  for (int n = 0; n < 3; n++) qC[n] = SV[n] = dC[n] = f32x4{0, 0, 0, 0};
#pragma unroll
  for (int ks = 0; ks < 2; ks++) {
    bf16x8 qa = ldfrag(sQ + (16 * w + fr) * 72 + ks * 32 + fq * 8);
    bf16x8 sa = ldfrag(sS + (16 * w + fr) * 72 + ks * 32 + fq * 8);
    bf16x8 ka = ldfrag(sKT + (16 * w + fr) * 72 + ((((ks * 4 + fq) ^ (2 * w + (fr >> 3))) & 7) * 8));
#pragma unroll
    for (int n = 0; n < 3; n++) {
      bf16x8 cbf = ldfrag(sCT + (n * 16 + fr) * 72 + ks * 32 + fq * 8);
      bf16x8 vbf = ldfrag(sVT + (n * 16 + fr) * 72 + ((((ks * 4 + fq) ^ (2 * n + (fr >> 3))) & 7) * 8));
      qC[n] = MFMA(qa, cbf, qC[n]);
      SV[n] = MFMA(sa, vbf, SV[n]);
      dC[n] = MFMA(ka, vbf, dC[n]);
    }
  }
#pragma unroll
  for (int j = 0; j < 4; j++) {
    int i = 16 * w + fq * 4 + j;
    float pm_i = sPm[i], b_i = sBv[i];
    float rho = __expf(fminf(0.f, pm_i - m_st)), inter = __expf(fminf(0.f, m_st - pm_i));
    float qn = qC[2][j], rs = SV[2][j];
    float denom = inter * qn + rho * rs;
    float m_i = b_i + fmaxf(pm_i, m_st);
    float dn = 1.f / fmaxf(fabsf(denom), __expf(-m_i));
    size_t t = tbase + cb + (d ? 63 - i : i);
#pragma unroll
    for (int n = 0; n < 2; n++)
      if (!(x.vf & 1)) og[t * 512 + h * 128 + sl * 32 + n * 16 + fr] = f2bf((inter * qC[n][j] + rho * SV[n][j]) * dn);
      else asm volatile("" ::"v"((inter * qC[n][j] + rho * SV[n][j]) * dn));
  }
  {
    float sig = __expf(fminf(0.f, pm_last - m_st)), dec = __expf(fminf(0.f, m_st - pm_last));
#pragma unroll
    for (int n = 0; n < 3; n++) Cacc[n] = Cacc[n] * dec + dC[n] * sig;
    m_st = b_last + fmaxf(m_st, pm_last);
  }
  lds_barrier();
}
__device__ __forceinline__ void ml_scan_item(const Params& p, int l, int item, char* smem, int vf = 0) {
  MlCtx x;
  x.vf = vf;
  x.tid = otid(); x.lane = x.tid & 63; x.w = x.tid >> 6; x.fr = x.lane & 15; x.fq = x.lane >> 4;
  x.sl = item & 3; x.d = (item >> 2) & 1; x.h = (item >> 3) & 3;
  const int bl = item >> 5;
  x.sQ = (u16*)smem;
  x.sK = x.sQ + 64 * 72;
  x.sKT = x.sK + 64 * 72;
  x.sS = x.sKT + 64 * 72;
  x.sVT = x.sS + 64 * 72;
  x.sCT = x.sVT + 48 * 72;
  x.sGall = (float*)(x.sCT + 48 * 72);
  x.tbase = (size_t)bl * SEQ;
  x.og = x.d ? p.MLhb : (p.Aqkv + (size_t)2 * TH * 512);
  x.ib = p.ml_i_bias[l * 8 + x.d * 4 + x.h];
  x.fb = p.ml_f_bias[l * 8 + x.d * 4 + x.h];
  for (int e = x.tid; e < 16 * 72; e += 256) x.sVT[32 * 72 + e] = (u16)0x3f80;
  f32x4 Cacc[3];
  Cacc[0] = Cacc[1] = Cacc[2] = f32x4{0, 0, 0, 0};
  float m_st = 0.f;
  MlStep sa, sb;
  MlG g0, g1, g2;
  ml_load(sa, p, x.tbase, x.h, x.d, x.sl, 0, x.tid);
  ml_gload(g0, p, x.tbase, x.h, x.d, 0, x.lane);
  ml_gload(g1, p, x.tbase, x.h, x.d, 1, x.lane);
  if (x.w == 0) ml_gates(g0, x.lane, x.ib, x.fb, x.sGall);
  __syncthreads();
  for (int cn = 0; cn < 32; cn += 2) {
    if (!(vf & 2) || cn == 0) { ml_load(sb, p, x.tbase, x.h, x.d, x.sl, cn + 1, x.tid);
    ml_gload(g2, p, x.tbase, x.h, x.d, min(cn + 2, 31), x.lane); }
    ml_step(p, sa, g1, Cacc, m_st, x, cn);
    if (!(vf & 2)) { if (cn + 2 < 32) ml_load(sa, p, x.tbase, x.h, x.d, x.sl, cn + 2, x.tid);
    ml_gload(g1, p, x.tbase, x.h, x.d, min(cn + 3, 31), x.lane); }
    ml_step(p, sb, g2, Cacc, m_st, x, cn + 1);
  }
  __syncthreads();
}

template <int DH, int MT, bool NA>
__device__ __forceinline__ void attn_item(const u16* __restrict__ qbase, int ldq, const u16* __restrict__ kbase, int ldkv,
                                          const u16* __restrict__ vtbase, u16* __restrict__ obase, int ldo, int nkt,
                                          float scale, int r, int r0, const float* __restrict__ rpbh, char* smem) {
  const int tid = otid(), lane = tid & 63, w = tid >> 6, fr = lane & 15, fq = lane >> 4;
  constexpr int KS = DH / 32, ND = DH / 16, CPT = DH / 32, SPR = DH / 8;
  constexpr int KB = 64 * DH * 2, VB = DH * 128;
  char* sKb = smem;
  char* sVb = smem + 2 * KB;
  bf16x8 qf[MT][KS];
#pragma unroll
  for (int m = 0; m < MT; m++)
#pragma unroll
    for (int ks = 0; ks < KS; ks++)
      qf[m][ks] = ldfrag(qbase + (size_t)(w * 16 * MT + m * 16 + fr) * ldq + ks * 32 + fq * 8);
  f32x4 O[MT][ND];
  float mrow[MT], lrow[MT];
#pragma unroll
  for (int m = 0; m < MT; m++) {
#pragma unroll
    for (int n = 0; n < ND; n++) O[m][n] = f32x4{0, 0, 0, 0};
    mrow[m] = -1e30f;
    lrow[m] = 0.f;
  }
  const int koff = (tid / SPR) * ldkv + (((tid % SPR) ^ ((tid / SPR) & (SPR - 1))) * 8);
  const int voff = (tid >> 3) * SEQ + (((tid & 7) ^ ((tid >> 3) & 7)) * 8);
  auto gload = [&](int kt) {
    const u16* kg = kbase + (size_t)kt * 64 * ldkv;
    const u16* vg = vtbase + kt * 64;
    char* kdst = sKb + (kt & 1) * KB;
    char* vdst = sVb + (kt & 1) * VB;
#pragma unroll
    for (int i = 0; i < CPT; i++) {
      __builtin_amdgcn_global_load_lds((const unsigned*)(kg + koff + i * (256 / SPR) * ldkv),
                                       (unsigned*)(kdst + (tid + i * 256) * 16), 16, 0, 0);
      __builtin_amdgcn_global_load_lds((const unsigned*)(vg + voff + i * 32 * SEQ),
                                       (unsigned*)(vdst + (tid + i * 256) * 16), 16, 0, 0);
    }
  };
  gload(0);
  for (int kt = 0; kt < nkt; kt++) {
    const char* sKc = sKb + (kt & 1) * KB;
    const char* sVc = sVb + (kt & 1) * VB;
    asm volatile("s_waitcnt vmcnt(0)" ::: "memory");
    __builtin_amdgcn_s_barrier();
    if (kt + 1 < nkt) gload(kt + 1);
    f32x4 sT[MT][4];
#pragma unroll
    for (int m = 0; m < MT; m++)
#pragma unroll
      for (int n = 0; n < 4; n++) sT[m][n] = f32x4{0, 0, 0, 0};
#pragma unroll
    for (int ks = 0; ks < KS; ks++) {
#pragma unroll
      for (int n = 0; n < 4; n++) {
        bf16x8 kb = *(const bf16x8*)(sKc + (n * 16 + fr) * (DH * 2) + (((ks * 4 + fq) ^ (fr & (SPR - 1))) * 16));
#pragma unroll
        for (int m = 0; m < MT; m++) sT[m][n] = MFMA(kb, qf[m][ks], sT[m][n]);
      }
    }
    bf16x8 pb[MT][2];
#pragma unroll
    for (int m = 0; m < MT; m++) {
      float mx = -1e30f;
#pragma unroll
      for (int n = 0; n < 4; n++)
#pragma unroll
        for (int j = 0; j < 4; j++) {
          float v = sT[m][n][j];
          if (NA) {
            int cq = w * 16 * MT + m * 16 + fr, kc = n * 16 + fq * 4 + j;
            int c0 = min(max(cq - 8, 0), 48);
            bool ok = (kc >= c0) && (kc < c0 + 16);
            v = ok ? fmaf(rpbh[(r0 + kt - r + 7) * 31 + (kc - cq + 15)], 1.4426950408889634f, v) : -1e30f;
          }
          sT[m][n][j] = v;
          mx = fmaxf(mx, v);
        }
      mx = fmaxf(mx, __shfl_xor(mx, 16));
      mx = fmaxf(mx, __shfl_xor(mx, 32));
      const bool moved = mx > mrow[m] + 8.f;
      const float mnew = moved ? mx : mrow[m];
      if (__any(moved)) {
        float alpha = __builtin_amdgcn_exp2f(mrow[m] - mnew);
        lrow[m] *= alpha;
#pragma unroll
        for (int n = 0; n < ND; n++) O[m][n] *= alpha;
        mrow[m] = mnew;
      }
      float sum = 0.f;
#pragma unroll
      for (int n = 0; n < 4; n++)
#pragma unroll
        for (int j = 0; j < 4; j++) {
          float pv = __builtin_amdgcn_exp2f(sT[m][n][j] - mnew);
          sT[m][n][j] = pv;
          sum += pv;
        }
      sum += __shfl_xor(sum, 16);
      sum += __shfl_xor(sum, 32);
      lrow[m] += sum;
#pragma unroll
      for (int t = 0; t < 2; t++) {
        u32x4 pk;
        pk[0] = pack2(sT[m][2 * t][0], sT[m][2 * t][1]);
        pk[1] = pack2(sT[m][2 * t][2], sT[m][2 * t][3]);
        pk[2] = pack2(sT[m][2 * t + 1][0], sT[m][2 * t + 1][1]);
        pk[3] = pack2(sT[m][2 * t + 1][2], sT[m][2 * t + 1][3]);
        pb[m][t] = __builtin_bit_cast(bf16x8, pk);
      }
    }
#pragma unroll
    for (int t = 0; t < 2; t++) {
#pragma unroll
      for (int n = 0; n < ND; n++) {
        const char* vrow = sVc + (n * 16 + fr) * 128 + (fq & 1) * 8;
        u32x2 lo = *(const u32x2*)(vrow + (((4 * t + (fq >> 1)) ^ (fr & 7)) * 16));
        u32x2 hi = *(const u32x2*)(vrow + (((4 * t + 2 + (fq >> 1)) ^ (fr & 7)) * 16));
        u32x4 va = {lo[0], lo[1], hi[0], hi[1]};
        bf16x8 vaf = __builtin_bit_cast(bf16x8, va);
#pragma unroll
        for (int m = 0; m < MT; m++) O[m][n] = MFMA(vaf, pb[m][t], O[m][n]);
      }
    }
  }
  __builtin_amdgcn_s_barrier();
  const int tid2 = otid(), w2 = tid2 >> 6, fr2 = tid2 & 15, fq2 = (tid2 >> 4) & 3;
#pragma unroll
  for (int m = 0; m < MT; m++) {
    float il = 1.f / lrow[m];
    int row = w2 * 16 * MT + m * 16 + fr2;
#pragma unroll
    for (int n = 0; n < ND; n++) {
      u32x2* dp = (u32x2*)(obase + (size_t)row * ldo + n * 16 + fq2 * 4);
      u32x2 zz = *dp, o;
      o.x = pack2(O[m][n][0] * il * bf2f((u16)(zz.x & 0xffff)), O[m][n][1] * il * __uint_as_float(zz.x & 0xffff0000u));
      o.y = pack2(O[m][n][2] * il * bf2f((u16)(zz.y & 0xffff)), O[m][n][3] * il * __uint_as_float(zz.y & 0xffff0000u));
      *dp = o;
    }
  }
}

constexpr int N_DN = BP * 4 * 2 * 4, N_ML = N_DN, N_GA = BP * 4 * 16, N_NA = BP * 8 * 32;
__device__ __forceinline__ void phase_M(const Params& p, int l, int* ctr, char* smem) {
  const int xcd = blockIdx.x & 7;
  volatile LAS int* s_item_p = ((volatile LAS int*)&g_xb_words) + 2;
  constexpr int Q_DN = N_DN / 8, Q_ML = N_ML / 8, Q_GA = N_GA / 8, Q_NA = N_NA / 8;
  for (;;) {
    if (threadIdx.x == 0) *s_item_p = atomicAdd(ctr + xcd, 1);
    __syncthreads();
    int q = *s_item_p;
    __syncthreads();
    if (q >= Q_DN + Q_ML + Q_GA + Q_NA) break;
    if (q < Q_DN) q = q;
    else if (q < Q_DN + Q_GA / 2) q = Q_DN + Q_ML + (q - Q_DN);
    else if (q < Q_DN + Q_GA / 2 + Q_ML) q = Q_DN + (q - Q_DN - Q_GA / 2);
    else if (q < Q_DN + Q_ML + Q_GA) q = Q_DN + Q_ML + Q_GA / 2 + (q - Q_DN - Q_GA / 2 - Q_ML);
    if (q < Q_DN) {
      dn_scan_item(p, ((q >> 2) * 8 + xcd) * 4 + (q & 3), smem);
    } else if (q < Q_DN + Q_ML) {
      int u = q - Q_DN;
      ml_scan_item(p, l, ((u >> 2) * 8 + xcd) * 4 + (u & 3), smem);
    } else if (q < Q_DN + Q_ML + Q_GA) {
      int u = q - Q_DN - Q_ML;
      int grp = (u >> 5) * 8 + xcd, bl = grp >> 1, kvh = grp & 1, v = u & 31, hq = kvh * 2 + (v >> 4), qb = v & 15;
      u16* base = p.Cqkv + (size_t)bl * SEQ * 768;
      attn_item<128, 2, false>(base + (size_t)qb * 128 * 768 + hq * 128, 768, base + 512 + kvh * 128, 768,
                               p.VtC + (size_t)(bl * 2 + kvh) * 128 * SEQ,
                               p.Z + ((size_t)bl * SEQ + qb * 128) * 2560 + 1024 + hq * 128, 2560, 32, 0.08838834764831845f, 0, 0,
                               nullptr, smem);
    } else {
      int u = q - Q_DN - Q_ML - Q_GA;
      int grp = (u >> 5) * 8 + xcd, bl = grp >> 3, h = grp & 7, r = u & 31;
      int r0 = min(max(r - 4, 0), 24);
      u16* base = p.Bqkv + (size_t)bl * SEQ * 1024;
      attn_item<64, 1, true>(base + (size_t)r * 64 * 1024 + h * 64, 1024, base + (size_t)r0 * 64 * 1024 + 512 + h * 64, 1024,
                             p.VtB + (size_t)(bl * 8 + h) * 64 * SEQ + r0 * 64,
                             p.Z + ((size_t)bl * SEQ + r * 64) * 2560 + 512 + h * 64, 2560, 8, 0.125f, r, r0,
                             p.na_rpb + ((size_t)l * 8 + h) * 15 * 31, smem);
    }
  }
}

__device__ __forceinline__ void phase_F1(const Params& p, int l) {
  const int tid_ = otid(), lane = tid_ & 63, gw = blockIdx.x * 4 + (tid_ >> 6), nw = gridDim.x * 4;
  const u16* of = p.Aqkv;
  const u16* ob = p.Aqkv + (size_t)TH * 512;
  const u16* hf = p.Aqkv + (size_t)2 * TH * 512;
  const u16* hb = p.MLhb;
  for (int t = gw; t < TH; t += nw) {
    u16* z = p.Z + (size_t)t * 2560;
    const int e0 = lane * 8;
    float y[8];
    {
      u32x4 a = *(const u32x4*)(of + (size_t)t * 512 + e0), b = *(const u32x4*)(ob + (size_t)t * 512 + e0);
      u32x4 zz = *(const u32x4*)(z + e0);
      const u16 *pa = (const u16*)&a, *pb = (const u16*)&b, *pz = (const u16*)&zz;
      float ss = 0.f;
#pragma unroll
      for (int e = 0; e < 8; e++) { y[e] = bf2f(pa[e]) + bf2f(pb[e]); ss += y[e] * y[e]; }
      ss = grp16_sum(ss);
      float sc = rsqrtf(ss * (1.f / 128.f) + EPS);
      u32x4 ov;
      u16* o = (u16*)&ov;
#pragma unroll
      for (int e = 0; e < 8; e++) o[e] = f2bf(y[e] * sc * p.dn_norm_g[l * 128 + ((e0 + e) & 127)] * bf2f(pz[e]));
      *(u32x4*)(z + e0) = ov;
    }
    {
      u32x4 a = *(const u32x4*)(hf + (size_t)t * 512 + e0), b = *(const u32x4*)(hb + (size_t)t * 512 + e0);
      u32x4 zz = *(const u32x4*)(z + 1536 + e0), oz = *(const u32x4*)(z + 2048 + e0);
      const u16 *pa = (const u16*)&a, *pb = (const u16*)&b, *pz = (const u16*)&zz, *po = (const u16*)&oz;
      float ss = 0.f;
#pragma unroll
      for (int e = 0; e < 8; e++) { y[e] = bf2f(pa[e]) + bf2f(pb[e]); ss += y[e] * y[e]; }
      ss = grp16_sum(ss);
      float sc = rsqrtf(ss * (1.f / 128.f) + EPS);
      u32x4 ov;
      u16* o = (u16*)&ov;
#pragma unroll
      for (int e = 0; e < 8; e++)
        o[e] = f2bf(y[e] * sc * p.ml_norm_g[l * 128 + ((e0 + e) & 127)] * bf2f(pz[e]) * bf2f(po[e]));
      *(u32x4*)(z + 1536 + e0) = ov;
    }
  }
}

__device__ __forceinline__ void phase_F3(const Params& p, int l, char* smem) {
  const int tid = otid(), lane = tid & 63, w = tid >> 6, wm = w >> 1, wn = w & 1, fr = lane & 15, fq = lane >> 4;
  const u16* Wg = p.WinT + ((size_t)l * NWIN + NW1) * D;
  const u16* Wb = p.WbT + (size_t)l * 4 * D * 512;
  u16* merged = p.qkvc;
  constexpr int NT = 8, MTL = TH / 128;
  for (int id = blockIdx.x; id < NT * MTL; id += gridDim.x) {
    int mt, nt;
    tile_of(id, NT * MTL, NT, mt, nt);
    f32x4 accm[4][4];
    ZERO_ACC2(accm, 4, 4);
    for (int n = 0; n < 4; n++) {
      u32x2 gpk[4][4];
      {
        f32x4 accg[4][4];
        ZERO_ACC2(accg, 4, 4);
        gemm_dma<4, 4, true>(accg, p.hbuf + (size_t)mt * 128 * D, D, Wg + ((size_t)n * 1024 + nt * 128) * D, D, D, smem);
#pragma unroll
        for (int m = 0; m < 4; m++)
#pragma unroll
          for (int nn = 0; nn < 4; nn++) {
            float g0 = fmaxf(sigmoidf_(accg[m][nn][0]), 1e-6f), g1 = fmaxf(sigmoidf_(accg[m][nn][1]), 1e-6f);
            float g2 = fmaxf(sigmoidf_(accg[m][nn][2]), 1e-6f), g3 = fmaxf(sigmoidf_(accg[m][nn][3]), 1e-6f);
            gpk[m][nn].x = pack2(g0, g1);
            gpk[m][nn].y = pack2(g2, g3);
            accm[m][nn][0] = accm[m][nn][0] / bf2f((u16)(gpk[m][nn].x & 0xffff));
            accm[m][nn][1] = accm[m][nn][1] / bf2f((u16)(gpk[m][nn].x >> 16));
            accm[m][nn][2] = accm[m][nn][2] / bf2f((u16)(gpk[m][nn].y & 0xffff));
            accm[m][nn][3] = accm[m][nn][3] / bf2f((u16)(gpk[m][nn].y >> 16));
          }
      }
      gemm_dma<4, 4, true>(accm, p.Z + (size_t)mt * 128 * 2560 + n * 512, 2560, Wb + ((size_t)n * 1024 + nt * 128) * 512,
                           512, 512, smem);
#pragma unroll
      for (int m = 0; m < 4; m++)
#pragma unroll
        for (int nn = 0; nn < 4; nn++) {
          accm[m][nn][0] *= bf2f((u16)(gpk[m][nn].x & 0xffff));
          accm[m][nn][1] *= bf2f((u16)(gpk[m][nn].x >> 16));
          accm[m][nn][2] *= bf2f((u16)(gpk[m][nn].y & 0xffff));
          accm[m][nn][3] *= bf2f((u16)(gpk[m][nn].y >> 16));
        }
    }
    {
      const int te = otid(), fr = te & 15, fq = (te >> 4) & 3, wm = te >> 7, wn = (te >> 6) & 1;
#pragma unroll
      for (int m = 0; m < 4; m++)
#pragma unroll
        for (int nn = 0; nn < 4; nn++) {
          const int row = mt * 128 + wm * 64 + m * 16 + fr, col0 = nt * 128 + wn * 64 + nn * 16 + fq * 4;
          u32x2 o;
          o.x = pack2(accm[m][nn][0], accm[m][nn][1]);
          o.y = pack2(accm[m][nn][2], accm[m][nn][3]);
          *(u32x2*)(merged + (size_t)row * D + col0) = o;
        }
    }
  }
}

__device__ __forceinline__ void phase_F4(const Params& p, int l, const float* __restrict__ xin,
                                         float* __restrict__ xout, char* smem) {
  const int tid = otid(), lane = tid & 63, w = tid >> 6, wm = w >> 1, wn = w & 1, fr = lane & 15, fq = lane >> 4;
  const u16* Wo = p.WoT + (size_t)l * D * D;
  const u16* merged = p.qkvc;
  constexpr int NT = 8, MTL = TH / 256;
  for (int id = blockIdx.x; id < NT * MTL; id += gridDim.x) {
    int mt, nt;
    tile_of(id, NT * MTL, NT, mt, nt);
    f32x4 acc[8][4];
    ZERO_ACC2(acc, 8, 4);
    gemm_dma<8, 4, true>(acc, merged + (size_t)mt * 256 * D, D, Wo + (size_t)nt * 128 * D, D, D, smem);
    {
      const int te = otid(), fr = te & 15, fq = (te >> 4) & 3, wm = te >> 7, wn = (te >> 6) & 1;
#pragma unroll
      for (int m = 0; m < 8; m++)
#pragma unroll
        for (int nn = 0; nn < 4; nn++) {
          const size_t off = (size_t)(mt * 256 + wm * 128 + m * 16 + fr) * D + nt * 128 + wn * 64 + nn * 16 + fq * 4;
          f32x4 xi = *(const f32x4*)(xin + off);
          *(f32x4*)(xout + off) = xi + acc[m][nn];
        }
    }
  }
}

#define XB_TMO 128
#define XB_XCNT(j) (256 + 64 * (j))
#define XB_XSUB(j) (1280 + 64 * (j))
#define XB_XGEN(j) (2304 + 64 * (j))
#define XB_TOP 3328
#define XB_TOPGEN 3392
#define XCD_BAR_WORDS 3456
#define XB_SPIN_CAP (1u << 20)
__device__ __forceinline__ unsigned xb_ld(unsigned* p) { return __hip_atomic_load(p, __ATOMIC_RELAXED, __HIP_MEMORY_SCOPE_AGENT); }
__device__ __forceinline__ unsigned xb_add(unsigned* p, unsigned v) {
  return __hip_atomic_fetch_add(p, v, __ATOMIC_RELAXED, __HIP_MEMORY_SCOPE_AGENT);
}
__device__ __forceinline__ unsigned xb_xcc_id() { return (unsigned)__builtin_amdgcn_s_getreg((3 << 11) | 20) & 0xFu; }
#define XB_SPIN(cond, bar)                                                      \
  do {                                                                          \
    unsigned _sp = 0;                                                           \
    while (cond) {                                                              \
      __builtin_amdgcn_s_sleep(1);                                              \
      if ((++_sp & 255u) == 0u) {                                               \
        if (xb_ld(&(bar)[XB_TMO])) break;                                       \
        if (_sp > XB_SPIN_CAP) { atomicAdd(&(bar)[XB_TMO], 1u); break; }        \
      }                                                                         \
    }                                                                           \
  } while (0)
struct XcdBarrier { unsigned* bar; };
__device__ __forceinline__ XcdBarrier xcd_barrier_post(unsigned* bar) {
  XcdBarrier b; b.bar = bar;
  if (threadIdx.x == 0) (void)xb_add(&bar[XB_XCNT(xb_xcc_id())], 1u);
  return b;
}
__device__ __forceinline__ void xcd_barrier_complete(unsigned* bar, unsigned x, unsigned& nloc, unsigned& nx) {
  const unsigned G = gridDim.x * gridDim.y * gridDim.z;
  unsigned sum, cnt, mine, sp = 0u;
  for (;;) {
    sum = 0u; cnt = 0u; mine = 0u;
#pragma unroll
    for (unsigned j = 0; j < 16; ++j) {
      const unsigned c = xb_ld(&bar[XB_XCNT(j)]);
      sum += c; cnt += (c > 0u) ? 1u : 0u; mine = (j == x) ? c : mine;
    }
    if (sum == G) break;
    __builtin_amdgcn_s_sleep(1);
    if ((++sp & 255u) == 0u) {
      if (xb_ld(&bar[XB_TMO])) break;
      if (sp > XB_SPIN_CAP) { atomicAdd(&bar[XB_TMO], 1u); break; }
    }
  }
  nloc = mine > 0u ? mine : 1u; nx = cnt > 0u ? cnt : 1u;
}
__device__ __forceinline__ void xcd_barrier(const XcdBarrier& b) {
  asm volatile("s_waitcnt vmcnt(0)" ::: "memory");
  __syncthreads();
  if (threadIdx.x == 0) {
    unsigned* bar = b.bar;
    __builtin_amdgcn_s_waitcnt(0);
    volatile LAS unsigned* st = (volatile LAS unsigned*)&g_xb_words;
    const unsigned bx = xb_xcc_id();
    unsigned nloc = st[0], nx = st[1];
    if (nloc == 0u) { xcd_barrier_complete(bar, bx, nloc, nx); st[0] = nloc; st[1] = nx; }
    const unsigned old = xb_add(&bar[XB_XSUB(bx)], 1u);
    const unsigned gen = old / nloc;
    if (old + 1u == (gen + 1u) * nloc) {
      __builtin_amdgcn_fence(__ATOMIC_RELEASE, "agent");
      asm volatile("s_waitcnt vmcnt(0)" ::: "memory");
      const unsigned og = xb_add(&bar[XB_TOP], 1u);
      const unsigned tg = og / nx;
      if (og + 1u == (tg + 1u) * nx) xb_add(&bar[XB_TOPGEN], 1u);
      else XB_SPIN(xb_ld(&bar[XB_TOPGEN]) == tg, bar);
      __builtin_amdgcn_fence(__ATOMIC_ACQUIRE, "agent");
      xb_add(&bar[XB_XGEN(bx)], 1u);
      asm volatile("s_waitcnt vmcnt(0)" ::: "memory");
    } else {
      XB_SPIN(xb_ld(&bar[XB_XGEN(bx)]) == gen, bar);
      __builtin_amdgcn_fence(__ATOMIC_ACQUIRE, "agent");
      asm volatile("s_waitcnt vmcnt(0)" ::: "memory");
    }
  }
  __syncthreads();
}

__global__ void __launch_bounds__(256, 2) mega(Params p) {
  cg::grid_group grid = cg::this_grid();
  extern __shared__ __attribute__((aligned(16))) char smem[];
  if (threadIdx.x == 0) g_xb_words = make_uint4(0u, 0u, 0u, 0u);
  __syncthreads();
  XcdBarrier xb = xcd_barrier_post(p.bar);
  if (p.use_cg) grid.sync();
#ifndef DUP
#define DUP 0
#endif
  phase_W(p, smem);
  phase_R(p.x, p.norm_g, p.hbuf);
  xcd_barrier(xb);
  for (int l = 0; l < DEPTH; l++) {
    for (int ps = 0; ps < NPASS; ps++) {
      const float* xin = (l == 0 ? p.x : p.out) + (size_t)ps * TH * D;
      float* xout = p.out + (size_t)ps * TH * D;
      phase_G1(p, l, smem);
      xcd_barrier(xb);
      phase_P2(p, l, smem);
      xcd_barrier(xb);
      phase_M(p, l, p.ctr + (l * NPASS + ps) * 8, smem);
      xcd_barrier(xb);
      phase_F1(p, l);
      xcd_barrier(xb);
      phase_F3(p, l, smem);
      xcd_barrier(xb);
      phase_F4(p, l, xin, xout, smem);
      {
        const int ps2 = (ps + 1 == NPASS) ? 0 : ps + 1, l2 = (ps + 1 == NPASS) ? l + 1 : l;
        if (l2 < DEPTH) phase_R((l2 == 0 ? p.x : p.out) + (size_t)ps2 * TH * D, p.norm_g + l2 * D, p.hbuf);
      }
      xcd_barrier(xb);
    }
  }
}

extern "C" void kernel_launch(void* const* d_in, const int* in_sizes, int n_in, void* d_out, int out_size,
                              void* d_ws, size_t ws_size, hipStream_t stream) {
  static int grid_blocks = 0;
  if (!grid_blocks) {
    (void)hipFuncSetAttribute((const void*)mega, hipFuncAttributeMaxDynamicSharedMemorySize, (int)LDS_BYTES);
    int dev = 0, cus = 0, per_cu = 0;
    (void)hipGetDevice(&dev);
    (void)hipDeviceGetAttribute(&cus, hipDeviceAttributeMultiprocessorCount, dev);
    (void)hipOccupancyMaxActiveBlocksPerMultiprocessor(&per_cu, mega, 256, LDS_BYTES);
    if (per_cu > 2) per_cu = 2;
    grid_blocks = cus * per_cu;
  }
  Params p{};
  const float* const* in = (const float* const*)d_in;
  p.x = in[0]; p.norm_g = in[1]; p.w_in = in[2]; p.conv_a = in[3]; p.dn_a_log = in[4]; p.dn_dt_bias = in[5];
  p.dn_norm_g = in[6]; p.na_q_norm = in[7]; p.na_k_norm = in[8]; p.na_rpb = in[9]; p.ga_q_norm = in[10];
  p.ga_k_norm = in[11]; p.ml_i_bias = in[12]; p.ml_f_bias = in[13]; p.ml_norm_g = in[14]; p.w_branch = in[15];
  p.w_out = in[16];
  p.out = (float*)d_out;
  char* ws = (char*)d_ws;
  size_t off = 0;
  auto take = [&](size_t bytes) { char* r = ws + off; off += (bytes + 255) & ~(size_t)255; return r; };
  p.ctr = (int*)take(1024);
  p.bar = (unsigned*)take(XCD_BAR_WORDS * 4);
  p.use_cg = 0; p.pad = 0;
  p.WinT = (u16*)take((size_t)DEPTH * NWIN * D * 2);
  p.WbT = (u16*)take((size_t)DEPTH * 4 * D * 512 * 2);
  p.WoT = (u16*)take((size_t)DEPTH * D * D * 2);
  p.hbuf = (u16*)take((size_t)TH * D * 2);
  p.Aqkv = (u16*)take((size_t)TH * 1536 * 2);
  p.Bqkv = (u16*)take((size_t)TH * 1024 * 2);
  p.Cqkv = (u16*)take((size_t)TH * 768 * 2);
  p.Dqkv = (u16*)take((size_t)TH * 1024 * 2);
  p.Z = (u16*)take((size_t)TH * 2560 * 2);
  p.Sm = (float*)take((size_t)TH * 32 * 4);
  p.qkvc = (u16*)take((size_t)TH * 1536 * 2);
  p.TP = (u16*)take((size_t)NCHK * 2 * 2 * 4096 * 2);
  p.KdT = (u16*)take((size_t)NCHK * 2 * 8192 * 2);
  p.vecs = (float*)take((size_t)NCHK * 2 * 144 * 4);
  p.MLhb = (u16*)take((size_t)TH * 512 * 2);
  p.Bo = (u16*)take((size_t)TH * 512 * 2);
  p.Co = (u16*)take((size_t)TH * 512 * 2);
  p.VtB = (u16*)take((size_t)TH * 512 * 2);
  p.VtC = (u16*)take((size_t)TH * 256 * 2);
  if (off > ws_size) return;
  (void)hipMemsetAsync(p.ctr, 0, 1024 + ((XCD_BAR_WORDS * 4 + 255) & ~255), stream);
  void* args[] = {&p};
  (void)hipLaunchCooperativeKernel((void*)mega, dim3(grid_blocks), dim3(256), args, LDS_BYTES, stream);
}
```

```cpp
#include <hip/hip_runtime.h>
#include <hip/hip_cooperative_groups.h>
namespace cg = cooperative_groups;

typedef unsigned short u16;
using bf16x8 = __attribute__((ext_vector_type(8))) short;
using f32x4 = __attribute__((ext_vector_type(4))) float;
using u32x4 = __attribute__((ext_vector_type(4))) unsigned;
using u32x2 = __attribute__((ext_vector_type(2))) unsigned;

constexpr int D = 1024, SEQ = 2048, BATCH = 16, DEPTH = 2, PROJW = 11808;
constexpr int NPASS = 2, BP = BATCH / NPASS, TH = BP * SEQ;
constexpr int NW1 = 7808;
constexpr int NWIN = NW1 + 4096;
constexpr float EPS = 1e-6f;
constexpr int NCHK = BP * 4 * 32;
constexpr size_t LDS_BYTES = 73728;

struct Params {
  const float* x; const float* norm_g; const float* w_in; const float* conv_a; const float* dn_a_log;
  const float* dn_dt_bias; const float* dn_norm_g; const float* na_q_norm; const float* na_k_norm;
  const float* na_rpb; const float* ga_q_norm; const float* ga_k_norm; const float* ml_i_bias;
  const float* ml_f_bias; const float* ml_norm_g; const float* w_branch; const float* w_out;
  float* out;
  u16* WinT; u16* WbT; u16* WoT;
  u16* hbuf; u16* Aqkv; u16* Bqkv; u16* Cqkv; u16* Dqkv; u16* Z; float* Sm; u16* qkvc;
  u16* TP; u16* KdT; float* vecs; u16* MLhb; u16* Bo; u16* Co; u16* VtB; u16* VtC; int* ctr; unsigned* bar; int use_cg; int pad;
};

#define LAS __attribute__((address_space(3)))
__shared__ uint4 g_xb_words;

typedef float f32x2_t __attribute__((ext_vector_type(2)));
typedef __bf16 bf16x2_t __attribute__((ext_vector_type(2)));
__device__ __forceinline__ unsigned pack2(float a, float b) {
  f32x2_t v = {a, b};
  return __builtin_bit_cast(unsigned, __builtin_convertvector(v, bf16x2_t));
}
__device__ __forceinline__ u16 f2bf(float f) { return __builtin_bit_cast(u16, (__bf16)f); }
__device__ __forceinline__ float bf2f(u16 h) { return __uint_as_float(((unsigned)h) << 16); }
__device__ __forceinline__ float wave_sum(float v) {
#pragma unroll
  for (int o = 32; o >= 1; o >>= 1) v += __shfl_xor(v, o);
  return v;
}
__device__ __forceinline__ float grp16_sum(float v) {
#pragma unroll
  for (int o = 8; o >= 1; o >>= 1) v += __shfl_xor(v, o);
  return v;
}
__device__ __forceinline__ float grp16_max(float v) {
#pragma unroll
  for (int o = 8; o >= 1; o >>= 1) v = fmaxf(v, __shfl_xor(v, o));
  return v;
}
__device__ __forceinline__ float sigmoidf_(float x) { return 1.f / (1.f + __expf(-x)); }
__device__ __forceinline__ float siluf_(float x) { return x / (1.f + __expf(-x)); }
__device__ __forceinline__ float softplusf_(float x) { return x > 20.f ? x : __logf(1.f + __expf(x)); }
__device__ __forceinline__ float logsigmoidf_(float x) { return fminf(x, 0.f) - __logf(1.f + __expf(-fabsf(x))); }
__device__ __forceinline__ int otid() {
  int t = threadIdx.x;
  asm volatile("" : "+v"(t));
  return t;
}
#define MFMA(a, b, c) __builtin_amdgcn_mfma_f32_16x16x32_bf16(a, b, c, 0, 0, 0)
__device__ __forceinline__ bf16x8 ldfrag(const u16* p) { return *reinterpret_cast<const bf16x8*>(p); }

__device__ __forceinline__ int win_src_col(int r) {
  if (r < 1536) return r;
  if (r < 3072) return 2064 + (r - 1536);
  if (r < 4096) return 4112 + (r - 3072);
  if (r < 5120) return 5648 + (r - 4096);
  if (r < 5632) return 1552 + (r - 5120);
  if (r < 6144) return 3600 + (r - 5632);
  if (r < 6656) return 5136 + (r - 6144);
  if (r < 7168) return 7200 + (r - 6656);
  if (r < 7680) return 6688 + (r - 7168);
  if (r < 7696) return 1536 + (r - 7680);
  if (r < 7712) return 6672 + (r - 7696);
  if (r < 7808) return -1;
  return 7712 + (r - 7808);
}
__device__ __forceinline__ void tr_tile(const float* __restrict__ src, int ldsrc, u16* __restrict__ dst, int K, int r0, int k0,
                        int mode, float* tile) {
  const int tid = otid();
  {
    int rr = tid & 63, kq = tid >> 6;
    int col = mode ? win_src_col(r0 + rr) : (r0 + rr);
    float v[16];
#pragma unroll
    for (int i = 0; i < 16; i++) v[i] = col >= 0 ? src[(size_t)(k0 + kq + 4 * i) * ldsrc + col] : 0.f;
#pragma unroll
    for (int i = 0; i < 16; i++) tile[(kq + 4 * i) * 65 + rr] = v[i];
  }
  __syncthreads();
  {
    int k2 = (tid & 31) * 2, rq = tid >> 5;
#pragma unroll
    for (int i = 0; i < 8; i++) {
      int r2 = rq + 8 * i;
      *(unsigned*)(dst + (size_t)(r0 + r2) * K + k0 + k2) = pack2(tile[k2 * 65 + r2], tile[(k2 + 1) * 65 + r2]);
    }
  }
  __syncthreads();
}
__device__ __forceinline__ void phase_W(const Params& p, char* smem) {
  float* tile = (float*)smem;
  constexpr int J_IN = (NWIN / 64) * 16, J_B = 4 * 16 * 8, J_O = 16 * 16, J_L = J_IN + J_B + J_O;
  for (int job = blockIdx.x; job < DEPTH * J_L; job += gridDim.x) {
    int l = job / J_L, j = job % J_L;
    if (j < J_IN) {
      int rt = j / 16, kt = j % 16;
      tr_tile(p.w_in + (size_t)l * D * PROJW, PROJW, p.WinT + (size_t)l * NWIN * D, D, rt * 64, kt * 64, 1, tile);
    } else if (j < J_IN + J_B) {
      j -= J_IN;
      int n = j / 128, q = j % 128, rt = q / 8, kt = q % 8;
      tr_tile(p.w_branch + ((size_t)l * 4 + n) * 512 * D, D, p.WbT + ((size_t)l * 4 + n) * D * 512, 512, rt * 64,
              kt * 64, 0, tile);
    } else {
      j -= J_IN + J_B;
      int rt = j / 16, kt = j % 16;
      tr_tile(p.w_out + (size_t)l * D * D, D, p.WoT + (size_t)l * D * D, D, rt * 64, kt * 64, 0, tile);
    }
  }
}

__device__ __forceinline__ void phase_R(const float* __restrict__ xin, const float* __restrict__ g, u16* __restrict__ hbuf) {
  const int tid_ = otid(), lane = tid_ & 63, gw = blockIdx.x * 4 + (tid_ >> 6), nw = gridDim.x * 4;
  for (int t = gw; t < TH; t += nw) {
    const float4* xr = (const float4*)(xin + (size_t)t * D);
    float4 v[4];
    float ss = 0.f;
#pragma unroll
    for (int i = 0; i < 4; i++) {
      v[i] = xr[i * 64 + lane];
      ss += v[i].x * v[i].x + v[i].y * v[i].y + v[i].z * v[i].z + v[i].w * v[i].w;
    }
    ss = wave_sum(ss);
    float sc = rsqrtf(ss * (1.f / D) + EPS);
#pragma unroll
    for (int i = 0; i < 4; i++) {
      float4 gg = ((const float4*)g)[i * 64 + lane];
      u32x2 o;
      o.x = pack2(v[i].x * sc * gg.x, v[i].y * sc * gg.y);
      o.y = pack2(v[i].z * sc * gg.z, v[i].w * sc * gg.w);
      *(u32x2*)(hbuf + (size_t)t * D + (i * 64 + lane) * 4) = o;
    }
  }
}

constexpr int LDSK = 72;
template <int NW>
__device__ __forceinline__ void gemm128(f32x4 (&acc)[4][NW], const u16* __restrict__ A, int lda,
                                        const u16* __restrict__ Bt, int ldb, int K, u16* sA, u16* sB) {
  const int tid = otid(), lane = tid & 63, w = tid >> 6, wm = w >> 1, wn = w & 1, fr = lane & 15, fq = lane >> 4;
  u32x4 ra[4], rb[NW];
#pragma unroll
  for (int i = 0; i < 4; i++) {
    int c = tid + i * 256, row = c >> 3, kc = c & 7;
    ra[i] = *(const u32x4*)(A + (size_t)row * lda + kc * 8);
    if (i < NW) rb[i] = *(const u32x4*)(Bt + (size_t)row * ldb + kc * 8);
  }
  for (int k0 = 0; k0 < K; k0 += 64) {
#pragma unroll
    for (int i = 0; i < 4; i++) {
      int c = tid + i * 256, row = c >> 3, kc = c & 7;
      *(u32x4*)(sA + row * LDSK + kc * 8) = ra[i];
      if (i < NW) *(u32x4*)(sB + row * LDSK + kc * 8) = rb[i];
    }
    __syncthreads();
    if (k0 + 64 < K) {
#pragma unroll
      for (int i = 0; i < 4; i++) {
        int c = tid + i * 256, row = c >> 3, kc = c & 7;
        ra[i] = *(const u32x4*)(A + (size_t)row * lda + k0 + 64 + kc * 8);
        if (i < NW) rb[i] = *(const u32x4*)(Bt + (size_t)row * ldb + k0 + 64 + kc * 8);
      }
    }
#pragma unroll
    for (int ks = 0; ks < 2; ks++) {
      bf16x8 af[4], bfr[NW];
#pragma unroll
      for (int m = 0; m < 4; m++) af[m] = ldfrag(sA + (wm * 64 + m * 16 + fr) * LDSK + ks * 32 + fq * 8);
#pragma unroll
      for (int n = 0; n < NW; n++) bfr[n] = ldfrag(sB + (wn * 16 * NW + n * 16 + fr) * LDSK + ks * 32 + fq * 8);
#pragma unroll
      for (int m = 0; m < 4; m++)
#pragma unroll
        for (int n = 0; n < NW; n++) acc[m][n] = MFMA(af[m], bfr[n], acc[m][n]);
    }
    __syncthreads();
  }
}
#define ZERO_ACC(a, NWV)                                                                                  \
  _Pragma("unroll") for (int m_ = 0; m_ < 4; m_++) _Pragma("unroll") for (int n_ = 0; n_ < NWV; n_++) a[m_][n_] = \
      f32x4{0.f, 0.f, 0.f, 0.f};

__device__ __forceinline__ int swz1k(int ob) { return ob ^ (((ob >> 9) & 1) << 5); }
template <int MW, int NW, bool SWAP = false>
__device__ __forceinline__ void gemm_dma(f32x4 (&acc)[MW][NW], const u16* __restrict__ A, int lda,
                                         const u16* __restrict__ Bt, int ldb, int K, char* smem) {
  constexpr int BM = 32 * MW, BN = 32 * NW, STG = (BM + BN) * 64, NLA = BM / 64, NLB = BN / 64, NL = NLA + NLB;
  const int tid = otid(), lane = tid & 63, w = tid >> 6, wm = w >> 1, wn = w & 1, fr = lane & 15, fq = lane >> 4;
  int offA[NLA], offB[NLB];
#pragma unroll
  for (int i = 0; i < NLA; i++) {
    int b = (tid + i * 256) * 16, st = b >> 10, sw = swz1k(b & 1023);
    offA[i] = (st * 16 + (sw >> 6)) * lda + ((sw & 63) >> 1);
  }
#pragma unroll
  for (int i = 0; i < NLB; i++) {
    int b = (tid + i * 256) * 16, st = b >> 10, sw = swz1k(b & 1023);
    offB[i] = (st * 16 + (sw >> 6)) * ldb + ((sw & 63) >> 1);
  }
  const int fo = swz1k(fr * 64 + fq * 16);
  const int nk = K >> 5;
  auto issue = [&](int t) {
    char* stg = smem + (t % 3) * STG;
#pragma unroll
    for (int i = 0; i < NLA; i++)
      __builtin_amdgcn_global_load_lds((const unsigned*)(A + offA[i] + t * 32), (unsigned*)(stg + (tid + i * 256) * 16), 16, 0,
                                       0);
#pragma unroll
    for (int i = 0; i < NLB; i++)
      __builtin_amdgcn_global_load_lds((const unsigned*)(Bt + offB[i] + t * 32),
                                       (unsigned*)(stg + BM * 64 + (tid + i * 256) * 16), 16, 0, 0);
  };
  issue(0);
  if (nk > 1) issue(1);
  for (int t = 0; t < nk; t++) {
    if (t + 1 < nk) asm volatile("s_waitcnt vmcnt(%0)" ::"n"(NL) : "memory");
    else asm volatile("s_waitcnt vmcnt(0)" ::: "memory");
    __builtin_amdgcn_s_barrier();
    const char* stg = smem + (t % 3) * STG;
    bf16x8 af[MW], bfr[NW];
#pragma unroll
    for (int m = 0; m < MW; m++) af[m] = *(const bf16x8*)(stg + (wm * MW + m) * 1024 + fo);
#pragma unroll
    for (int n = 0; n < NW; n++) bfr[n] = *(const bf16x8*)(stg + BM * 64 + (wn * NW + n) * 1024 + fo);
    if (t + 2 < nk) issue(t + 2);
    __builtin_amdgcn_s_setprio(1);
#pragma unroll
    for (int m = 0; m < MW; m++)
#pragma unroll
      for (int n = 0; n < NW; n++) acc[m][n] = SWAP ? MFMA(bfr[n], af[m], acc[m][n]) : MFMA(af[m], bfr[n], acc[m][n]);
    __builtin_amdgcn_s_setprio(0);
  }
  __builtin_amdgcn_s_barrier();
}
#define ZERO_ACC2(a, MWV, NWV)                                                                              \
  _Pragma("unroll") for (int m_ = 0; m_ < MWV; m_++) _Pragma("unroll") for (int n_ = 0; n_ < NWV; n_++) a[m_][n_] = \
      f32x4{0.f, 0.f, 0.f, 0.f};
__device__ __forceinline__ void tile_of(int id, int ntiles, int NT, int& mt, int& nt) {
  int q = (id & 7) * (ntiles >> 3) + (id >> 3);
  mt = (q / (NT * 8)) * 8 + (q & 7);
  nt = (q >> 3) % NT;
}

__device__ __forceinline__ void phase_G1(const Params& p, int l, char* smem) {
  const int tid = otid(), lane = tid & 63, w = tid >> 6, wm = w >> 1, wn = w & 1, fr = lane & 15, fq = lane >> 4;
  constexpr int NT = NW1 / 128, MTL = TH / 256;
  const u16* W = p.WinT + (size_t)l * NWIN * D;
  for (int id = blockIdx.x; id < NT * MTL; id += gridDim.x) {
    int mt, nt;
    tile_of(id, NT * MTL, NT, mt, nt);
    int n0 = nt * 128;
    u16* dst;
    int ldd, cb, act = 0, mode = 0;
    if (n0 < 1536) { dst = p.Aqkv; ldd = 1536; cb = n0; }
    else if (n0 < 3072) { dst = p.Bqkv; ldd = 1024; cb = n0 - 1536; mode = (cb < 1024) ? 1 : 3; }
    else if (n0 < 4096) { dst = p.Cqkv; ldd = 768; cb = n0 - 3072; mode = (cb < 768) ? 2 : 4; }
    else if (n0 < 5120) { dst = p.Dqkv; ldd = 1024; cb = n0 - 4096; }
    else if (n0 < 7680) { dst = p.Z; ldd = 2560; cb = n0 - 5120; act = (cb < 2048) ? 1 : 2; }
    else { dst = nullptr; ldd = 0; cb = 0; }
    f32x4 acc[8][4];
    ZERO_ACC2(acc, 8, 4);
    if (mode == 0) gemm_dma<8, 4, true>(acc, p.hbuf + (size_t)mt * 256 * D, D, W + (size_t)nt * 128 * D, D, D, smem);
    else gemm_dma<8, 4, false>(acc, p.hbuf + (size_t)mt * 256 * D, D, W + (size_t)nt * 128 * D, D, D, smem);
    if (mode == 1) {
      const int te = otid(), fr = te & 15, fq = (te >> 4) & 3, wm = te >> 7, wn = (te >> 6) & 1;
      const float* g = (cb < 512 ? p.na_q_norm : p.na_k_norm) + l * 64;
      float gv[4];
      const float qs = (cb < 512) ? 0.125f * 1.4426950408889634f : 1.f;
#pragma unroll
      for (int n = 0; n < 4; n++) gv[n] = g[n * 16 + fr] * qs;
#pragma unroll
      for (int m = 0; m < 8; m++)
#pragma unroll
        for (int j = 0; j < 4; j++) {
          float ss = 0.f;
#pragma unroll
          for (int n = 0; n < 4; n++) ss += acc[m][n][j] * acc[m][n][j];
          ss = grp16_sum(ss);
          float sc = rsqrtf(ss * (1.f / 64.f) + EPS);
          int row = mt * 256 + wm * 128 + m * 16 + fq * 4 + j;
#pragma unroll
          for (int n = 0; n < 4; n++)
            dst[(size_t)row * ldd + cb + wn * 64 + n * 16 + fr] = f2bf(acc[m][n][j] * sc * gv[n]);
        }
    } else if (mode == 2) {
      float* sX = (float*)smem;
      const int te = otid(), fr = te & 15, fq = (te >> 4) & 3, wm = te >> 7, wn = (te >> 6) & 1;
      const float* g = (cb < 512 ? p.ga_q_norm : p.ga_k_norm) + l * 128 + wn * 64;
      float gv[4];
      const float qs = (cb < 512) ? 0.08838834764831845f * 1.4426950408889634f : 1.f;
#pragma unroll
      for (int n = 0; n < 4; n++) gv[n] = g[n * 16 + fr] * qs;
#pragma unroll
      for (int m = 0; m < 8; m++)
#pragma unroll
        for (int j = 0; j < 4; j++) {
          float ss = 0.f;
#pragma unroll
          for (int n = 0; n < 4; n++) ss += acc[m][n][j] * acc[m][n][j];
          ss = grp16_sum(ss);
          if (fr == 0) sX[(wm * 128 + m * 16 + fq * 4 + j) * 2 + wn] = ss;
        }
      __syncthreads();
      float inv[2];
#pragma unroll
      for (int n = 0; n < 2; n++) inv[n] = exp2f(-(float)(n * 16 + fr) * (13.287712379549449f / 32.f));
#pragma unroll
      for (int m = 0; m < 8; m++)
#pragma unroll
        for (int j = 0; j < 4; j++) {
          int rl = wm * 128 + m * 16 + fq * 4 + j, row = mt * 256 + rl;
          float sc = rsqrtf((sX[rl * 2] + sX[rl * 2 + 1]) * (1.f / 128.f) + EPS);
          int ts = row & (SEQ - 1);
          float pos = wn ? (float)(ts & 63) : (float)(ts >> 6);
#pragma unroll
          for (int n = 0; n < 2; n++) {
            float ang = pos * inv[n];
            float kf = rintf(ang * 0.15915494309189535f);
            float rr = fmaf(-kf, 6.2831855f, ang);
            rr = fmaf(-kf, -1.7484555e-7f, rr);
            float sn = __sinf(rr), cs = __cosf(rr);
            float y1 = acc[m][n][j] * sc * gv[n], y2 = acc[m][n + 2][j] * sc * gv[n + 2];
            u16* o = dst + (size_t)row * ldd + cb + wn * 64 + n * 16 + fr;
            o[0] = f2bf(y1 * cs - y2 * sn);
            o[32] = f2bf(y1 * sn + y2 * cs);
          }
          __builtin_amdgcn_sched_barrier(0);
        }
      __syncthreads();
    } else if (mode >= 3) {
      const int te = otid(), fr = te & 15, fq = (te >> 4) & 3, wm = te >> 7, wn = (te >> 6) & 1;
      const int row0 = mt * 256 + wm * 128, bl = row0 >> 11;
      u16* vt;
      if (mode == 3) vt = p.VtB + ((size_t)(bl * 8 + ((cb - 1024) >> 6) + wn) * 64) * SEQ;
      else vt = p.VtC + ((size_t)(bl * 2 + ((cb - 768) >> 7)) * 128 + wn * 64) * SEQ;
#pragma unroll
      for (int m = 0; m < 8; m++)
#pragma unroll
        for (int n = 0; n < 4; n++) {
          u32x2 o;
          o.x = pack2(acc[m][n][0], acc[m][n][1]);
          o.y = pack2(acc[m][n][2], acc[m][n][3]);
          *(u32x2*)(vt + (size_t)(n * 16 + fr) * SEQ + ((row0 + m * 16 + fq * 4) & (SEQ - 1))) = o;
        }
    } else {
      const int te = otid(), fr = te & 15, fq = (te >> 4) & 3, wm = te >> 7, wn = (te >> 6) & 1;
#pragma unroll
      for (int m = 0; m < 8; m++)
#pragma unroll
        for (int n = 0; n < 4; n++) {
          const int row = mt * 256 + wm * 128 + m * 16 + fr, col0 = wn * 64 + n * 16 + fq * 4;
          f32x4 v = acc[m][n];
          if (dst) {
            if (act == 1) { v[0] = siluf_(v[0]); v[1] = siluf_(v[1]); v[2] = siluf_(v[2]); v[3] = siluf_(v[3]); }
            else if (act == 2) { v[0] = sigmoidf_(v[0]); v[1] = sigmoidf_(v[1]); v[2] = sigmoidf_(v[2]); v[3] = sigmoidf_(v[3]); }
            u32x2 o;
            o.x = pack2(v[0], v[1]);
            o.y = pack2(v[2], v[3]);
            *(u32x2*)(dst + (size_t)row * ldd + cb + col0) = o;
          } else if (col0 < 32) {
            *(f32x4*)(p.Sm + (size_t)row * 32 + col0) = v;
          }
        }
    }
  }
}

__device__ __forceinline__ void dn_prep_item(const Params& p, int l, int item, char* smem) {
  const int tid = otid(), lane = tid & 63, w = tid >> 6, fr = lane & 15, fq = lane >> 4;
  const int c = item & 31, h = (item >> 5) & 3, bl = item >> 7;
  u16* sQ = (u16*)smem;
  u16* sK = sQ + 64 * 136;
  float* sAm = (float*)(sK + 64 * 136);
  float* sBeta = sAm + 2 * 64 * 68;
  float* sGc = sBeta + 128;
  const size_t tbase = (size_t)bl * SEQ;
  const int t0 = c * 64;
  for (int part = 0; part < 3; part++) {
    const int ch = part * 512 + h * 128 + 2 * lane;
    float w0[5], w1[5];
#pragma unroll
    for (int j = 0; j < 5; j++) {
      w0[j] = p.conv_a[((size_t)l * 5 + j) * 1536 + ch];
      w1[j] = p.conv_a[((size_t)l * 5 + j) * 1536 + ch + 1];
    }
    const int rs = t0 + w * 16;
    unsigned xin[20];
#pragma unroll
    for (int r = 0; r < 20; r++) {
      int t = rs - 2 + r;
      xin[r] = (t >= 0 && t < SEQ) ? *(const unsigned*)(p.Aqkv + (tbase + t) * 1536 + ch) : 0u;
    }
    float y0[16], y1[16];
#pragma unroll
    for (int rr = 0; rr < 16; rr++) {
      float a0 = 0.f, a1 = 0.f;
#pragma unroll
      for (int j = 0; j < 5; j++) {
        a0 += w0[j] * bf2f((u16)(xin[rr + j] & 0xffff));
        a1 += w1[j] * bf2f((u16)(xin[rr + j] >> 16));
      }
      y0[rr] = siluf_(a0);
      y1[rr] = siluf_(a1);
    }
    if (part < 2) {
      float ss[16];
#pragma unroll
      for (int rr = 0; rr < 16; rr++) ss[rr] = y0[rr] * y0[rr] + y1[rr] * y1[rr];
#pragma unroll
      for (int o = 32; o >= 1; o >>= 1)
#pragma unroll
        for (int rr = 0; rr < 16; rr++) ss[rr] += __shfl_xor(ss[rr], o);
#pragma unroll
      for (int rr = 0; rr < 16; rr++) {
        float sc = rsqrtf(ss[rr] + EPS) * (part == 0 ? 0.08838834764831845f : 1.f);
        unsigned pk = pack2(y0[rr] * sc, y1[rr] * sc);
        *(unsigned*)((part == 0 ? sQ : sK) + (w * 16 + rr) * 136 + 2 * lane) = pk;
        *(unsigned*)(p.qkvc + (tbase + rs + rr) * 1536 + ch) = pk;
      }
    } else {
#pragma unroll
      for (int rr = 0; rr < 16; rr++) *(unsigned*)(p.qkvc + (tbase + rs + rr) * 1536 + ch) = pack2(y0[rr], y1[rr]);
    }
  }
  if (w < 2) {
    const int d = w, ip = lane;
    const int t = t0 + (d ? 63 - ip : ip);
    float apre = p.Sm[(tbase + t) * 32 + d * 4 + h];
    float bpre = p.Sm[(tbase + t) * 32 + 8 + d * 4 + h];
    float g = -__expf(p.dn_a_log[l * 8 + d * 4 + h]) * softplusf_(apre + p.dn_dt_bias[l * 8 + d * 4 + h]);
    float beta = 1.f / (1.f + __expf(-bpre));
    float gc = g;
#pragma unroll
    for (int off = 1; off < 64; off <<= 1) {
      float v = __shfl_up(gc, off);
      if (lane >= off) gc += v;
    }
    sBeta[d * 64 + ip] = beta;
    sGc[d * 64 + ip] = gc;
  }
  __syncthreads();
  {
    f32x4 akk[4], aqk[4];
#pragma unroll
    for (int n = 0; n < 4; n++) { akk[n] = f32x4{0, 0, 0, 0}; aqk[n] = f32x4{0, 0, 0, 0}; }
#pragma unroll
    for (int ks = 0; ks < 4; ks++) {
      bf16x8 fk = ldfrag(sK + (16 * w + fr) * 136 + ks * 32 + fq * 8);
      bf16x8 fqv = ldfrag(sQ + (16 * w + fr) * 136 + ks * 32 + fq * 8);
#pragma unroll
      for (int n = 0; n < 4; n++) {
        bf16x8 fb = ldfrag(sK + (n * 16 + fr) * 136 + ks * 32 + fq * 8);
        akk[n] = MFMA(fk, fb, akk[n]);
        aqk[n] = MFMA(fqv, fb, aqk[n]);
      }
    }
#pragma unroll
    for (int d = 0; d < 2; d++) {
      u16* Pg = p.TP + ((size_t)(item * 2 + d) * 2 + 1) * 4096;
#pragma unroll
      for (int n = 0; n < 4; n++)
#pragma unroll
        for (int j = 0; j < 4; j++) {
          int i = 16 * w + fq * 4 + j, jj = n * 16 + fr;
          int ip = d ? 63 - i : i, jp = d ? 63 - jj : jj;
          float e = (jp <= ip) ? __expf(sGc[d * 64 + ip] - sGc[d * 64 + jp]) : 0.f;
          float av = (jp < ip) ? sBeta[d * 64 + ip] * akk[n][j] * e : 0.f;
          sAm[(d * 64 + ip) * 68 + jp] = av;
          Pg[ip * 64 + jp] = f2bf(aqk[n][j] * e);
        }
    }
  }
  __syncthreads();
  {
#pragma unroll
    for (int d = 0; d < 2; d++) {
      int jp = lane, j = d ? 63 - jp : jp;
      float e = __expf(sGc[d * 64 + 63] - sGc[d * 64 + jp]);
      u16* Kg = p.KdT + (size_t)(item * 2 + d) * 8192;
#pragma unroll
      for (int c8 = 0; c8 < 4; c8++) {
        const int dk0 = w * 32 + c8 * 8;
        u32x4 kv = *(const u32x4*)(sK + j * 136 + dk0);
#pragma unroll
        for (int e2 = 0; e2 < 4; e2++) {
          Kg[(dk0 + 2 * e2) * 64 + jp] = f2bf(bf2f((u16)(kv[e2] & 0xffff)) * e);
          Kg[(dk0 + 2 * e2 + 1) * 64 + jp] = f2bf(bf2f((u16)(kv[e2] >> 16)) * e);
        }
      }
    }
    if (w >= 2) {
      int d = w - 2;
      float* vb = p.vecs + (size_t)(item * 2 + d) * 144;
      vb[lane] = sBeta[d * 64 + lane];
      vb[64 + lane] = __expf(sGc[d * 64 + lane]);
      if (lane == 0) vb[128] = __expf(sGc[d * 64 + 63]);
    }
  }
  if (w < 2) {
    const int d = w;
    const float* Am = sAm + d * 64 * 68;
    int cc = lane;
    asm volatile("" : "+v"(cc));
    float x[64];
#pragma unroll
    for (int i = 0; i < 64; i++) {
      float s = (i == cc) ? 1.f : 0.f;
#pragma unroll
      for (int j = 0; j < i; j++) s -= Am[i * 68 + j] * x[j];
      x[i] = s;
      __builtin_amdgcn_sched_barrier(0);
    }
    u16* Tg = p.TP + ((size_t)(item * 2 + d) * 2 + 0) * 4096;
#pragma unroll
    for (int i = 0; i < 64; i++) Tg[i * 64 + cc] = f2bf(x[i]);
  }
  __syncthreads();
}

__device__ __forceinline__ void phase_P2(const Params& p, int l, char* smem) {
  for (int item = blockIdx.x; item < NCHK; item += gridDim.x) dn_prep_item(p, l, item, smem);
}

__device__ __forceinline__ void lds_barrier() { asm volatile("s_waitcnt lgkmcnt(0)\n\ts_barrier" ::: "memory"); }
struct DnStep {
  bf16x8 ka[4], ta[2];
  float v[2][4], beta[4], egc[4], gtot;
};
struct DnLate {
  bf16x8 qa[4], pa[2], kd[2][2];
};
__device__ __forceinline__ void dn_load(DnStep& s, const Params& p, int bl, int h, int d, int sl, int cn, int w,
                                        int fr, int fq) {
  const int c = d ? 31 - cn : cn;
  const int pd = (((bl * 4 + h) * 32 + c) * 2 + d);
  const u16* Tg = p.TP + (size_t)pd * 8192;
  const float* vb = p.vecs + (size_t)pd * 144;
  const size_t tb = (size_t)bl * SEQ + c * 64;
  const int ipA = 16 * w + fr;
  const u16* krow = p.qkvc + (tb + (d ? 63 - ipA : ipA)) * 1536 + 512 + h * 128;
#pragma unroll
  for (int ks = 0; ks < 4; ks++) s.ka[ks] = ldfrag(krow + ks * 32 + fq * 8);
#pragma unroll
  for (int ks = 0; ks < 2; ks++) s.ta[ks] = ldfrag(Tg + (16 * w + fr) * 64 + ks * 32 + fq * 8);
#pragma unroll
  for (int j = 0; j < 4; j++) {
    int ip = 16 * w + fq * 4 + j;
    s.beta[j] = vb[ip];
    s.egc[j] = vb[64 + ip];
    size_t t = tb + (d ? 63 - ip : ip);
#pragma unroll
    for (int n = 0; n < 2; n++) s.v[n][j] = bf2f(p.qkvc[t * 1536 + 1024 + h * 128 + sl * 32 + n * 16 + fr]);
  }
  s.gtot = vb[128];
}
__device__ __forceinline__ void dn_load_q(DnLate& s, const Params& p, int bl, int h, int d, int cn, int w, int fr,
                                          int fq) {
  const int c = d ? 31 - cn : cn;
  const size_t tb = (size_t)bl * SEQ + c * 64;
  const int ipA = 16 * w + fr;
  const u16* qrow = p.qkvc + (tb + (d ? 63 - ipA : ipA)) * 1536 + h * 128;
#pragma unroll
  for (int ks = 0; ks < 4; ks++) s.qa[ks] = ldfrag(qrow + ks * 32 + fq * 8);
}
__device__ __forceinline__ void dn_load_pk(DnLate& s, const Params& p, int bl, int h, int d, int cn, int w, int fr,
                                           int fq) {
  const int c = d ? 31 - cn : cn;
  const int pd = (((bl * 4 + h) * 32 + c) * 2 + d);
  const u16* Pg = p.TP + (size_t)pd * 8192 + 4096;
  const u16* Kg = p.KdT + (size_t)pd * 8192;
#pragma unroll
  for (int ks = 0; ks < 2; ks++) {
    s.pa[ks] = ldfrag(Pg + (16 * w + fr) * 64 + ks * 32 + fq * 8);
#pragma unroll
    for (int m = 0; m < 2; m++) s.kd[m][ks] = ldfrag(Kg + (32 * w + m * 16 + fr) * 64 + ks * 32 + fq * 8);
  }
}
__device__ __forceinline__ void dn_step(const Params& p, int bl, const DnStep& cur, DnLate& lt, f32x4 (&Sacc)[2][2],
                                        u16* sST, u16* sRT, u16* sVnT, u16* og, size_t tbase, int cn, int d, int h,
                                        int sl, int w, int fr, int fq) {
  const int c = d ? 31 - cn : cn;
  const int cb = c * 64;
  const int cnn = cn + 1 < 32 ? cn + 1 : 31;
#pragma unroll
  for (int m = 0; m < 2; m++)
#pragma unroll
    for (int n = 0; n < 2; n++) {
      u32x2 o;
      o.x = pack2(Sacc[m][n][0], Sacc[m][n][1]);
      o.y = pack2(Sacc[m][n][2], Sacc[m][n][3]);
      *(u32x2*)(sST + (n * 16 + fr) * 136 + 32 * w + m * 16 + fq * 4) = o;
    }
  lds_barrier();
  f32x4 kS[2];
  kS[0] = kS[1] = f32x4{0, 0, 0, 0};
#pragma unroll
  for (int ks = 0; ks < 4; ks++) {
#pragma unroll
    for (int n = 0; n < 2; n++) kS[n] = MFMA(cur.ka[ks], ldfrag(sST + (n * 16 + fr) * 136 + ks * 32 + fq * 8), kS[n]);
  }
#pragma unroll
  for (int n = 0; n < 2; n++) {
    float r[4];
#pragma unroll
    for (int j = 0; j < 4; j++) r[j] = cur.beta[j] * (cur.v[n][j] - cur.egc[j] * kS[n][j]);
    u32x2 o;
    o.x = pack2(r[0], r[1]);
    o.y = pack2(r[2], r[3]);
    *(u32x2*)(sRT + (n * 16 + fr) * 72 + 16 * w + fq * 4) = o;
  }
  lds_barrier();
  f32x4 vn[2];
  vn[0] = vn[1] = f32x4{0, 0, 0, 0};
#pragma unroll
  for (int ks = 0; ks < 2; ks++)
#pragma unroll
    for (int n = 0; n < 2; n++) vn[n] = MFMA(cur.ta[ks], ldfrag(sRT + (n * 16 + fr) * 72 + ks * 32 + fq * 8), vn[n]);
  f32x4 qS[2];
  qS[0] = qS[1] = f32x4{0, 0, 0, 0};
#pragma unroll
  for (int ks = 0; ks < 4; ks++) {
#pragma unroll
    for (int n = 0; n < 2; n++) qS[n] = MFMA(lt.qa[ks], ldfrag(sST + (n * 16 + fr) * 136 + ks * 32 + fq * 8), qS[n]);
  }
  dn_load_q(lt, p, bl, h, d, cnn, w, fr, fq);
#pragma unroll
  for (int n = 0; n < 2; n++) {
    u32x2 o;
    o.x = pack2(vn[n][0], vn[n][1]);
    o.y = pack2(vn[n][2], vn[n][3]);
    *(u32x2*)(sVnT + (n * 16 + fr) * 72 + 16 * w + fq * 4) = o;
  }
  lds_barrier();
  f32x4 oo[2];
  oo[0] = oo[1] = f32x4{0, 0, 0, 0};
#pragma unroll
  for (int m = 0; m < 2; m++)
#pragma unroll
    for (int n = 0; n < 2; n++) Sacc[m][n] *= cur.gtot;
#pragma unroll
  for (int ks = 0; ks < 2; ks++) {
    bf16x8 vbf[2];
#pragma unroll
    for (int n = 0; n < 2; n++) vbf[n] = ldfrag(sVnT + (n * 16 + fr) * 72 + ks * 32 + fq * 8);
#pragma unroll
    for (int n = 0; n < 2; n++) oo[n] = MFMA(lt.pa[ks], vbf[n], oo[n]);
#pragma unroll
    for (int m = 0; m < 2; m++)
#pragma unroll
      for (int n = 0; n < 2; n++) Sacc[m][n] = MFMA(lt.kd[m][ks], vbf[n], Sacc[m][n]);
  }
#pragma unroll
  for (int n = 0; n < 2; n++)
#pragma unroll
    for (int j = 0; j < 4; j++) {
      int ip = 16 * w + fq * 4 + j;
      size_t t = tbase + cb + (d ? 63 - ip : ip);
      og[t * 512 + h * 128 + sl * 32 + n * 16 + fr] = f2bf(cur.egc[j] * qS[n][j] + oo[n][j]);
    }
  dn_load_pk(lt, p, bl, h, d, cnn, w, fr, fq);
}
__device__ __forceinline__ void dn_scan_item(const Params& p, int item, char* smem) {
  const int tid = otid(), lane = tid & 63, w = tid >> 6, fr = lane & 15, fq = lane >> 4;
  const int sl = item & 3, d = (item >> 2) & 1, h = (item >> 3) & 3, bl = item >> 5;
  u16* sST = (u16*)smem;
  u16* sRT = sST + 32 * 136;
  u16* sVnT = sRT + 32 * 72;
  const size_t tbase = (size_t)bl * SEQ;
  u16* og = p.Aqkv + (size_t)d * TH * 512;
  f32x4 Sacc[2][2];
#pragma unroll
  for (int m = 0; m < 2; m++)
#pragma unroll
    for (int n = 0; n < 2; n++) Sacc[m][n] = f32x4{0, 0, 0, 0};
  DnStep sa, sb;
  DnLate lt;
  dn_load(sa, p, bl, h, d, sl, 0, w, fr, fq);
  dn_load_q(lt, p, bl, h, d, 0, w, fr, fq);
  dn_load_pk(lt, p, bl, h, d, 0, w, fr, fq);
  __syncthreads();
  for (int cn = 0; cn < 32; cn += 2) {
    dn_load(sb, p, bl, h, d, sl, cn + 1, w, fr, fq);
    dn_step(p, bl, sa, lt, Sacc, sST, sRT, sVnT, og, tbase, cn, d, h, sl, w, fr, fq);
    if (cn + 2 < 32) dn_load(sa, p, bl, h, d, sl, cn + 2, w, fr, fq);
    dn_step(p, bl, sb, lt, Sacc, sST, sRT, sVnT, og, tbase, cn + 1, d, h, sl, w, fr, fq);
  }
  __syncthreads();
}

struct MlStep { u32x4 q[2], k[2], v; };
__device__ __forceinline__ void ml_load(MlStep& s, const Params& p, size_t tbase, int h, int d, int sl, int cn,
                                        int tid) {
  const int c = d ? 31 - cn : cn, cb = c * 64;
#pragma unroll
  for (int i = 0; i < 2; i++) {
    int cidx = tid + i * 256, ip = cidx >> 3, kc = cidx & 7;
    const size_t t = tbase + cb + (d ? 63 - ip : ip);
    s.q[i] = *(const u32x4*)(p.Dqkv + t * 1024 + h * 64 + kc * 8);
    s.k[i] = *(const u32x4*)(p.Dqkv + t * 1024 + 256 + h * 64 + kc * 8);
  }
  {
    int ip = tid >> 2, kc = tid & 3;
    const size_t t = tbase + cb + (d ? 63 - ip : ip);
    s.v = *(const u32x4*)(p.Dqkv + t * 1024 + 512 + h * 128 + sl * 32 + kc * 8);
  }
}
struct MlG { float ipre, fpre; };
__device__ __forceinline__ void ml_gload(MlG& g, const Params& p, size_t tbase, int h, int d, int cn, int lane) {
  const int c = d ? 31 - cn : cn, cb = c * 64, ip = lane;
  const size_t t = tbase + cb + (d ? 63 - ip : ip);
  g.ipre = p.Sm[t * 32 + 16 + d * 4 + h];
  g.fpre = p.Sm[t * 32 + 24 + d * 4 + h];
}
__device__ __forceinline__ void ml_gates(const MlG& g, int lane, float ib, float fb, float* sG) {
  const int ip = lane;
  float ig = g.ipre + ib;
  float lf = logsigmoidf_(g.fpre + fb);
  float b = lf;
#pragma unroll
  for (int off = 1; off < 64; off <<= 1) {
    float v = __shfl_up(b, off);
    if (lane >= off) b += v;
  }
  float a = ig - b;
  float pm = a;
#pragma unroll
  for (int off = 1; off < 64; off <<= 1) {
    float v = __shfl_up(pm, off);
    if (lane >= off) pm = fmaxf(pm, v);
  }
  const float pml = __shfl(pm, 63);
  sG[ip] = a;
  sG[64 + ip] = pm;
  sG[128 + ip] = b;
  sG[192 + ip] = __expf(a - pml);
  sG[256 + ip] = 0.125f * __expf(fminf(pml - pm, 80.f));
}
struct MlCtx {
  u16 *sQ, *sK, *sKT, *sS, *sVT, *sCT;
  float* sGall;
  u16* og;
  size_t tbase;
  float ib, fb;
  int h, d, sl, tid, lane, w, fr, fq, vf;
};
__device__ __forceinline__ void ml_step(const Params& p, const MlStep& cur, const MlG& gnext, f32x4 (&Cacc)[3],
                                        float& m_st, const MlCtx& x, int cn) {
  u16 *sQ = x.sQ, *sK = x.sK, *sKT = x.sKT, *sS = x.sS, *sVT = x.sVT, *sCT = x.sCT;
  float* sGall = x.sGall;
  u16* og = x.og;
  const size_t tbase = x.tbase;
  const float ib = x.ib, fb = x.fb;
  const int h = x.h, d = x.d, sl = x.sl, tid = x.tid, lane = x.lane, w = x.w, fr = x.fr, fq = x.fq;
    const int c = d ? 31 - cn : cn;
  const int cb = c * 64;
  const float* sA = sGall + (cn & 1) * 320;
  const float* sEa = sA + 192;
  const float* sEp = sA + 256;
  const float* sPm = sA + 64;
  const float* sBv = sA + 128;
  const float pm_last = sPm[63], b_last = sBv[63];
#pragma unroll
  for (int i = 0; i < 2; i++) {
    int cidx = tid + i * 256, ip = cidx >> 3, kc = cidx & 7;
    *(u32x4*)(sQ + ip * 72 + kc * 8) = cur.q[i];
    *(u32x4*)(sK + ip * 72 + kc * 8) = cur.k[i];
    u32x4 uk = cur.k[i];
    float wsc = sEa[ip] * 0.125f;
    u16* dst = sKT + (kc * 8) * 72 + ((((ip >> 3) ^ kc) & 7) * 8) + (ip & 7);
#pragma unroll
    for (int e = 0; e < 4; e++) {
      unsigned pk = pack2(bf2f((u16)(uk[e] & 0xffff)) * wsc, __uint_as_float(uk[e] & 0xffff0000u) * wsc);
      dst[(2 * e) * 72] = (u16)(pk & 0xffff);
      dst[(2 * e + 1) * 72] = (u16)(pk >> 16);
    }
  }
  {
    int ip = tid >> 2, kc = tid & 3;
    u32x4 uv = cur.v;
    u16* dst = sVT + (kc * 8) * 72 + ((((ip >> 3) ^ kc) & 7) * 8) + (ip & 7);
#pragma unroll
    for (int e = 0; e < 4; e++) {
      dst[(2 * e) * 72] = (u16)(uv[e] & 0xffff);
      dst[(2 * e + 1) * 72] = (u16)(uv[e] >> 16);
    }
  }
#pragma unroll
  for (int n = 0; n < 3; n++) {
    u32x2 o;
    o.x = pack2(Cacc[n][0], Cacc[n][1]);
    o.y = pack2(Cacc[n][2], Cacc[n][3]);
    *(u32x2*)(sCT + (n * 16 + fr) * 72 + 16 * w + fq * 4) = o;
  }
  lds_barrier();
  if (w == 3 && cn + 1 < 32) ml_gates(gnext, lane, ib, fb, sGall + ((cn + 1) & 1) * 320);
  {
    f32x4 s1[4];
#pragma unroll
    for (int n = 0; n < 4; n++) s1[n] = f32x4{0, 0, 0, 0};
#pragma unroll
    for (int ks = 0; ks < 2; ks++) {
      bf16x8 qa = ldfrag(sQ + (16 * w + fr) * 72 + ks * 32 + fq * 8);
#pragma unroll
      for (int n = 0; n < 4; n++) s1[n] = MFMA(qa, ldfrag(sK + (n * 16 + fr) * 72 + ks * 32 + fq * 8), s1[n]);
    }
    float eaj[4], epi[4];
#pragma unroll
    for (int n = 0; n < 4; n++) eaj[n] = sEa[n * 16 + fr];
#pragma unroll
    for (int j = 0; j < 4; j++) epi[j] = sEp[16 * w + fq * 4 + j];
#pragma unroll
    for (int n = 0; n < 4; n++)
#pragma unroll
      for (int j = 0; j < 4; j++) {
        int i = 16 * w + fq * 4 + j, jj = n * 16 + fr;
        float v = s1[n][j] * eaj[n] * epi[j];
        sS[i * 72 + jj] = f2bf(jj <= i ? v : 0.f);
      }
  }
  lds_barrier();
  f32x4 qC[3], SV[3], dC[3];
#pragma unroll
  for (int n = 0; n < 3; n++) qC[n] = SV[n] = dC[n] = f32x4{0, 0, 0, 0};
#pragma unroll
  for (int ks = 0; ks < 2; ks++) {
    bf16x8 qa = ldfrag(sQ + (16 * w + fr) * 72 + ks * 32 + fq * 8);
    bf16x8 sa = ldfrag(sS + (16 * w + fr) * 72 + ks * 32 + fq * 8);
    bf16x8 ka = ldfrag(sKT + (16 * w + fr) * 72 + ((((ks * 4 + fq) ^ (2 * w + (fr >> 3))) & 7) * 8));
#pragma unroll
    for (int n = 0; n < 3; n++) {
      bf16x8 cbf = ldfrag(sCT + (n * 16 + fr) * 72 + ks * 32 + fq * 8);
      bf16x8 vbf = ldfrag(sVT + (n * 16 + fr) * 72 + ((((ks * 4 + fq) ^ (2 * n + (fr >> 3))) & 7) * 8));
      qC[n] = MFMA(qa, cbf, qC[n]);
      SV[n] = MFMA(sa, vbf, SV[n]);
      dC[n] = MFMA(ka, vbf, dC[n]);
    }
  }
#pragma unroll
  for (int j = 0; j < 4; j++) {
    int i = 16 * w + fq * 4 + j;
    float pm_i = sPm[i], b_i = sBv[i];
    float rho = __expf(fminf(0.f, pm_i - m_st)), inter = __expf(fminf(0.f, m_st - pm_i));
    float qn = qC[2][j], rs = SV[2][j];
    float denom = inter * qn + rho * rs;
    float m_i = b_i + fmaxf(pm_i, m_st);
    float dn = 1.f / fmaxf(fabsf(denom), __expf(-m_i));
    size_t t = tbase + cb + (d ? 63 - i : i);
#pragma unroll
    for (int n = 0; n < 2; n++)
      if (!(x.vf & 1)) og[t * 512 + h * 128 + sl * 32 + n * 16 + fr] = f2bf((inter * qC[n][j] + rho * SV[n][j]) * dn);
      else asm volatile("" ::"v"((inter * qC[n][j] + rho * SV[n][j]) * dn));
  }
  {
    float sig = __expf(fminf(0.f, pm_last - m_st)), dec = __expf(fminf(0.f, m_st - pm_last));
#pragma unroll
    for (int n = 0; n < 3; n++) Cacc[n] = Cacc[n] * dec + dC[n] * sig;
    m_st = b_last + fmaxf(m_st, pm_last);
  }
  lds_barrier();
}
__device__ __forceinline__ void ml_scan_item(const Params& p, int l, int item, char* smem, int vf = 0) {
  MlCtx x;
  x.vf = vf;
  x.tid = otid(); x.lane = x.tid & 63; x.w = x.tid >> 6; x.fr = x.lane & 15; x.fq = x.lane >> 4;
  x.sl = item & 3; x.d = (item >> 2) & 1; x.h = (item >> 3) & 3;
  const int bl = item >> 5;
  x.sQ = (u16*)smem;
  x.sK = x.sQ + 64 * 72;
  x.sKT = x.sK + 64 * 72;
  x.sS = x.sKT + 64 * 72;
  x.sVT = x.sS + 64 * 72;
  x.sCT = x.sVT + 48 * 72;
  x.sGall = (float*)(x.sCT + 48 * 72);
  x.tbase = (size_t)bl * SEQ;
  x.og = x.d ? p.MLhb : (p.Aqkv + (size_t)2 * TH * 512);
  x.ib = p.ml_i_bias[l * 8 + x.d * 4 + x.h];
  x.fb = p.ml_f_bias[l * 8 + x.d * 4 + x.h];
  for (int e = x.tid; e < 16 * 72; e += 256) x.sVT[32 * 72 + e] = (u16)0x3f80;
  f32x4 Cacc[3];
  Cacc[0] = Cacc[1] = Cacc[2] = f32x4{0, 0, 0, 0};
  float m_st = 0.f;
  MlStep sa, sb;
  MlG g0, g1, g2;
  ml_load(sa, p, x.tbase, x.h, x.d, x.sl, 0, x.tid);
  ml_gload(g0, p, x.tbase, x.h, x.d, 0, x.lane);
  ml_gload(g1, p, x.tbase, x.h, x.d, 1, x.lane);
  if (x.w == 0) ml_gates(g0, x.lane, x.ib, x.fb, x.sGall);
  __syncthreads();
  for (int cn = 0; cn < 32; cn += 2) {
    if (!(vf & 2) || cn == 0) { ml_load(sb, p, x.tbase, x.h, x.d, x.sl, cn + 1, x.tid);
    ml_gload(g2, p, x.tbase, x.h, x.d, min(cn + 2, 31), x.lane); }
    ml_step(p, sa, g1, Cacc, m_st, x, cn);
    if (!(vf & 2)) { if (cn + 2 < 32) ml_load(sa, p, x.tbase, x.h, x.d, x.sl, cn + 2, x.tid);
    ml_gload(g1, p, x.tbase, x.h, x.d, min(cn + 3, 31), x.lane); }
    ml_step(p, sb, g2, Cacc, m_st, x, cn + 1);
  }
  __syncthreads();
}

template <int DH, int MT, bool NA>
__device__ __forceinline__ void attn_item(const u16* __restrict__ qbase, int ldq, const u16* __restrict__ kbase, int ldkv,
                                          const u16* __restrict__ vtbase, u16* __restrict__ obase, int ldo, int nkt,
                                          float scale, int r, int r0, const float* __restrict__ rpbh, char* smem) {
  const int tid = otid(), lane = tid & 63, w = tid >> 6, fr = lane & 15, fq = lane >> 4;
  constexpr int KS = DH / 32, ND = DH / 16, CPT = DH / 32, SPR = DH / 8;
  constexpr int NKT = NA ? 2 : 4, NTS = NA ? 1 : 2;
  const int kw = NA ? min(max(16 * w - 8, 0), 32) : 0;
  constexpr int KB = 64 * DH * 2, VB = DH * 128;
  char* sKb = smem;
  char* sVb = smem + 2 * KB;
  bf16x8 qf[MT][KS];
#pragma unroll
  for (int m = 0; m < MT; m++)
#pragma unroll
    for (int ks = 0; ks < KS; ks++)
      qf[m][ks] = ldfrag(qbase + (size_t)(w * 16 * MT + m * 16 + fr) * ldq + ks * 32 + fq * 8);
  f32x4 O[MT][ND];
  float mrow[MT], lrow[MT];
#pragma unroll
  for (int m = 0; m < MT; m++) {
#pragma unroll
    for (int n = 0; n < ND; n++) O[m][n] = f32x4{0, 0, 0, 0};
    mrow[m] = -1e30f;
    lrow[m] = 0.f;
  }
  const int koff = (tid / SPR) * ldkv + (((tid % SPR) ^ ((tid / SPR) & (SPR - 1))) * 8);
  const int voff = (tid >> 3) * SEQ + (((tid & 7) ^ ((tid >> 3) & 7)) * 8);
  auto gload = [&](int kt) {
    const u16* kg = kbase + (size_t)kt * 64 * ldkv;
    const u16* vg = vtbase + kt * 64;
    char* kdst = sKb + (kt & 1) * KB;
    char* vdst = sVb + (kt & 1) * VB;
#pragma unroll
    for (int i = 0; i < CPT; i++) {
      __builtin_amdgcn_global_load_lds((const unsigned*)(kg + koff + i * (256 / SPR) * ldkv),
                                       (unsigned*)(kdst + (tid + i * 256) * 16), 16, 0, 0);
      __builtin_amdgcn_global_load_lds((const unsigned*)(vg + voff + i * 32 * SEQ),
                                       (unsigned*)(vdst + (tid + i * 256) * 16), 16, 0, 0);
    }
  };
  gload(0);
  for (int kt = 0; kt < nkt; kt++) {
    const char* sKc = sKb + (kt & 1) * KB;
    const char* sVc = sVb + (kt & 1) * VB;
    asm volatile("s_waitcnt vmcnt(0)" ::: "memory");
    __builtin_amdgcn_s_barrier();
    if (kt + 1 < nkt) gload(kt + 1);
    f32x4 sT[MT][NKT];
#pragma unroll
    for (int m = 0; m < MT; m++)
#pragma unroll
      for (int n = 0; n < NKT; n++) sT[m][n] = f32x4{0, 0, 0, 0};
#pragma unroll
    for (int ks = 0; ks < KS; ks++) {
#pragma unroll
      for (int n = 0; n < NKT; n++) {
        const int krow = kw + n * 16 + fr;
        bf16x8 kb = *(const bf16x8*)(sKc + krow * (DH * 2) + (((ks * 4 + fq) ^ (krow & (SPR - 1))) * 16));
#pragma unroll
        for (int m = 0; m < MT; m++) sT[m][n] = MFMA(kb, qf[m][ks], sT[m][n]);
      }
    }
    bf16x8 pb[MT][NTS];
#pragma unroll
    for (int m = 0; m < MT; m++) {
      float mx = -1e30f;
#pragma unroll
      for (int n = 0; n < NKT; n++)
#pragma unroll
        for (int j = 0; j < 4; j++) {
          float v = sT[m][n][j];
          if (NA) {
            int cq = w * 16 * MT + m * 16 + fr, kc = kw + n * 16 + fq * 4 + j;
            int c0 = min(max(cq - 8, 0), 48);
            bool ok = (kc >= c0) && (kc < c0 + 16);
            v = ok ? fmaf(rpbh[(r0 + kt - r + 7) * 31 + (kc - cq + 15)], 1.4426950408889634f, v) : -1e30f;
          }
          sT[m][n][j] = v;
          mx = fmaxf(mx, v);
        }
      mx = fmaxf(mx, __shfl_xor(mx, 16));
      mx = fmaxf(mx, __shfl_xor(mx, 32));
      const bool moved = mx > mrow[m] + 8.f;
      const float mnew = moved ? mx : mrow[m];
      if (__any(moved)) {
        float alpha = __builtin_amdgcn_exp2f(mrow[m] - mnew);
        lrow[m] *= alpha;
#pragma unroll
        for (int n = 0; n < ND; n++) O[m][n] *= alpha;
        mrow[m] = mnew;
      }
      float sum = 0.f;
#pragma unroll
      for (int n = 0; n < NKT; n++)
#pragma unroll
        for (int j = 0; j < 4; j++) {
          float pv = __builtin_amdgcn_exp2f(sT[m][n][j] - mnew);
          sT[m][n][j] = pv;
          sum += pv;
        }
      sum += __shfl_xor(sum, 16);
      sum += __shfl_xor(sum, 32);
      lrow[m] += sum;
#pragma unroll
      for (int t = 0; t < NTS; t++) {
        u32x4 pk;
        pk[0] = pack2(sT[m][2 * t][0], sT[m][2 * t][1]);
        pk[1] = pack2(sT[m][2 * t][2], sT[m][2 * t][3]);
        pk[2] = pack2(sT[m][2 * t + 1][0], sT[m][2 * t + 1][1]);
        pk[3] = pack2(sT[m][2 * t + 1][2], sT[m][2 * t + 1][3]);
        pb[m][t] = __builtin_bit_cast(bf16x8, pk);
      }
    }
#pragma unroll
    for (int t = 0; t < NTS; t++) {
#pragma unroll
      for (int n = 0; n < ND; n++) {
        const int k0 = kw + 32 * t + fq * 4;
        const char* vrow = sVc + (n * 16 + fr) * 128 + (k0 & 7) * 2;
        u32x2 lo = *(const u32x2*)(vrow + ((((k0 >> 3)) ^ (fr & 7)) & 7) * 16);
        u32x2 hi = *(const u32x2*)(vrow + ((((k0 >> 3) + 2) ^ (fr & 7)) & 7) * 16);
        u32x4 va = {lo[0], lo[1], hi[0], hi[1]};
        bf16x8 vaf = __builtin_bit_cast(bf16x8, va);
#pragma unroll
        for (int m = 0; m < MT; m++) O[m][n] = MFMA(vaf, pb[m][t], O[m][n]);
      }
    }
  }
  __builtin_amdgcn_s_barrier();
  const int tid2 = otid(), w2 = tid2 >> 6, fr2 = tid2 & 15, fq2 = (tid2 >> 4) & 3;
#pragma unroll
  for (int m = 0; m < MT; m++) {
    float il = 1.f / lrow[m];
    int row = w2 * 16 * MT + m * 16 + fr2;
#pragma unroll
    for (int n = 0; n < ND; n++) {
      u32x2* dp = (u32x2*)(obase + (size_t)row * ldo + n * 16 + fq2 * 4);
      u32x2 zz = *dp, o;
      o.x = pack2(O[m][n][0] * il * bf2f((u16)(zz.x & 0xffff)), O[m][n][1] * il * __uint_as_float(zz.x & 0xffff0000u));
      o.y = pack2(O[m][n][2] * il * bf2f((u16)(zz.y & 0xffff)), O[m][n][3] * il * __uint_as_float(zz.y & 0xffff0000u));
      *dp = o;
    }
  }
}

constexpr int N_DN = BP * 4 * 2 * 4, N_ML = N_DN, N_GA = BP * 4 * 16, N_NA = BP * 8 * 32;
__device__ __forceinline__ void phase_M(const Params& p, int l, int* ctr, char* smem) {
  const int xcd = blockIdx.x & 7;
  volatile LAS int* s_item_p = ((volatile LAS int*)&g_xb_words) + 2;
  constexpr int Q_DN = N_DN / 8, Q_ML = N_ML / 8, Q_GA = N_GA / 8, Q_NA = N_NA / 8;
  for (;;) {
    if (threadIdx.x == 0) *s_item_p = atomicAdd(ctr + xcd, 1);
    __syncthreads();
    int q = *s_item_p;
    __syncthreads();
    if (q >= Q_DN + Q_ML + Q_GA + Q_NA) break;
    if (q < Q_DN) q = q;
    else if (q < Q_DN + Q_GA / 2) q = Q_DN + Q_ML + (q - Q_DN);
    else if (q < Q_DN + Q_GA / 2 + Q_ML) q = Q_DN + (q - Q_DN - Q_GA / 2);
    else if (q < Q_DN + Q_ML + Q_GA) q = Q_DN + Q_ML + Q_GA / 2 + (q - Q_DN - Q_GA / 2 - Q_ML);
    if (q < Q_DN) {
      dn_scan_item(p, ((q >> 2) * 8 + xcd) * 4 + (q & 3), smem);
    } else if (q < Q_DN + Q_ML) {
      int u = q - Q_DN;
      ml_scan_item(p, l, ((u >> 2) * 8 + xcd) * 4 + (u & 3), smem);
    } else if (q < Q_DN + Q_ML + Q_GA) {
      int u = q - Q_DN - Q_ML;
      int grp = (u >> 5) * 8 + xcd, bl = grp >> 1, kvh = grp & 1, v = u & 31, hq = kvh * 2 + (v >> 4), qb = v & 15;
      u16* base = p.Cqkv + (size_t)bl * SEQ * 768;
      attn_item<128, 2, false>(base + (size_t)qb * 128 * 768 + hq * 128, 768, base + 512 + kvh * 128, 768,
                               p.VtC + (size_t)(bl * 2 + kvh) * 128 * SEQ,
                               p.Z + ((size_t)bl * SEQ + qb * 128) * 2560 + 1024 + hq * 128, 2560, 32, 0.08838834764831845f, 0, 0,
                               nullptr, smem);
    } else {
      int u = q - Q_DN - Q_ML - Q_GA;
      int grp = (u >> 5) * 8 + xcd, bl = grp >> 3, h = grp & 7, r = u & 31;
      int r0 = min(max(r - 4, 0), 24);
      u16* base = p.Bqkv + (size_t)bl * SEQ * 1024;
      attn_item<64, 1, true>(base + (size_t)r * 64 * 1024 + h * 64, 1024, base + (size_t)r0 * 64 * 1024 + 512 + h * 64, 1024,
                             p.VtB + (size_t)(bl * 8 + h) * 64 * SEQ + r0 * 64,
                             p.Z + ((size_t)bl * SEQ + r * 64) * 2560 + 512 + h * 64, 2560, 8, 0.125f, r, r0,
                             p.na_rpb + ((size_t)l * 8 + h) * 15 * 31, smem);
    }
  }
}

__device__ __forceinline__ void phase_F1(const Params& p, int l) {
  const int tid_ = otid(), lane = tid_ & 63, gw = blockIdx.x * 4 + (tid_ >> 6), nw = gridDim.x * 4;
  const u16* of = p.Aqkv;
  const u16* ob = p.Aqkv + (size_t)TH * 512;
  const u16* hf = p.Aqkv + (size_t)2 * TH * 512;
  const u16* hb = p.MLhb;
  for (int t = gw; t < TH; t += nw) {
    u16* z = p.Z + (size_t)t * 2560;
    const int e0 = lane * 8;
    float y[8];
    {
      u32x4 a = *(const u32x4*)(of + (size_t)t * 512 + e0), b = *(const u32x4*)(ob + (size_t)t * 512 + e0);
      u32x4 zz = *(const u32x4*)(z + e0);
      const u16 *pa = (const u16*)&a, *pb = (const u16*)&b, *pz = (const u16*)&zz;
      float ss = 0.f;
#pragma unroll
      for (int e = 0; e < 8; e++) { y[e] = bf2f(pa[e]) + bf2f(pb[e]); ss += y[e] * y[e]; }
      ss = grp16_sum(ss);
      float sc = rsqrtf(ss * (1.f / 128.f) + EPS);
      u32x4 ov;
      u16* o = (u16*)&ov;
#pragma unroll
      for (int e = 0; e < 8; e++) o[e] = f2bf(y[e] * sc * p.dn_norm_g[l * 128 + ((e0 + e) & 127)] * bf2f(pz[e]));
      *(u32x4*)(z + e0) = ov;
    }
    {
      u32x4 a = *(const u32x4*)(hf + (size_t)t * 512 + e0), b = *(const u32x4*)(hb + (size_t)t * 512 + e0);
      u32x4 zz = *(const u32x4*)(z + 1536 + e0), oz = *(const u32x4*)(z + 2048 + e0);
      const u16 *pa = (const u16*)&a, *pb = (const u16*)&b, *pz = (const u16*)&zz, *po = (const u16*)&oz;
      float ss = 0.f;
#pragma unroll
      for (int e = 0; e < 8; e++) { y[e] = bf2f(pa[e]) + bf2f(pb[e]); ss += y[e] * y[e]; }
      ss = grp16_sum(ss);
      float sc = rsqrtf(ss * (1.f / 128.f) + EPS);
      u32x4 ov;
      u16* o = (u16*)&ov;
#pragma unroll
      for (int e = 0; e < 8; e++)
        o[e] = f2bf(y[e] * sc * p.ml_norm_g[l * 128 + ((e0 + e) & 127)] * bf2f(pz[e]) * bf2f(po[e]));
      *(u32x4*)(z + 1536 + e0) = ov;
    }
  }
}

__device__ __forceinline__ void phase_F3(const Params& p, int l, char* smem) {
  const int tid = otid(), lane = tid & 63, w = tid >> 6, wm = w >> 1, wn = w & 1, fr = lane & 15, fq = lane >> 4;
  const u16* Wg = p.WinT + ((size_t)l * NWIN + NW1) * D;
  const u16* Wb = p.WbT + (size_t)l * 4 * D * 512;
  u16* merged = p.qkvc;
  constexpr int NT = 8, MTL = TH / 128;
  for (int id = blockIdx.x; id < NT * MTL; id += gridDim.x) {
    int mt, nt;
    tile_of(id, NT * MTL, NT, mt, nt);
    f32x4 accm[4][4];
    ZERO_ACC2(accm, 4, 4);
    for (int n = 0; n < 4; n++) {
      u32x2 gpk[4][4];
      {
        f32x4 accg[4][4];
        ZERO_ACC2(accg, 4, 4);
        gemm_dma<4, 4, true>(accg, p.hbuf + (size_t)mt * 128 * D, D, Wg + ((size_t)n * 1024 + nt * 128) * D, D, D, smem);
#pragma unroll
        for (int m = 0; m < 4; m++)
#pragma unroll
          for (int nn = 0; nn < 4; nn++) {
            float g0 = fmaxf(sigmoidf_(accg[m][nn][0]), 1e-6f), g1 = fmaxf(sigmoidf_(accg[m][nn][1]), 1e-6f);
            float g2 = fmaxf(sigmoidf_(accg[m][nn][2]), 1e-6f), g3 = fmaxf(sigmoidf_(accg[m][nn][3]), 1e-6f);
            gpk[m][nn].x = pack2(g0, g1);
            gpk[m][nn].y = pack2(g2, g3);
            accm[m][nn][0] = accm[m][nn][0] / bf2f((u16)(gpk[m][nn].x & 0xffff));
            accm[m][nn][1] = accm[m][nn][1] / bf2f((u16)(gpk[m][nn].x >> 16));
            accm[m][nn][2] = accm[m][nn][2] / bf2f((u16)(gpk[m][nn].y & 0xffff));
            accm[m][nn][3] = accm[m][nn][3] / bf2f((u16)(gpk[m][nn].y >> 16));
          }
      }
      gemm_dma<4, 4, true>(accm, p.Z + (size_t)mt * 128 * 2560 + n * 512, 2560, Wb + ((size_t)n * 1024 + nt * 128) * 512,
                           512, 512, smem);
#pragma unroll
      for (int m = 0; m < 4; m++)
#pragma unroll
        for (int nn = 0; nn < 4; nn++) {
          accm[m][nn][0] *= bf2f((u16)(gpk[m][nn].x & 0xffff));
          accm[m][nn][1] *= bf2f((u16)(gpk[m][nn].x >> 16));
          accm[m][nn][2] *= bf2f((u16)(gpk[m][nn].y & 0xffff));
          accm[m][nn][3] *= bf2f((u16)(gpk[m][nn].y >> 16));
        }
    }
    {
      const int te = otid(), fr = te & 15, fq = (te >> 4) & 3, wm = te >> 7, wn = (te >> 6) & 1;
#pragma unroll
      for (int m = 0; m < 4; m++)
#pragma unroll
        for (int nn = 0; nn < 4; nn++) {
          const int row = mt * 128 + wm * 64 + m * 16 + fr, col0 = nt * 128 + wn * 64 + nn * 16 + fq * 4;
          u32x2 o;
          o.x = pack2(accm[m][nn][0], accm[m][nn][1]);
          o.y = pack2(accm[m][nn][2], accm[m][nn][3]);
          *(u32x2*)(merged + (size_t)row * D + col0) = o;
        }
    }
  }
}

__device__ __forceinline__ void phase_F4(const Params& p, int l, const float* __restrict__ xin,
                                         float* __restrict__ xout, char* smem) {
  const int tid = otid(), lane = tid & 63, w = tid >> 6, wm = w >> 1, wn = w & 1, fr = lane & 15, fq = lane >> 4;
  const u16* Wo = p.WoT + (size_t)l * D * D;
  const u16* merged = p.qkvc;
  constexpr int NT = 8, MTL = TH / 256;
  for (int id = blockIdx.x; id < NT * MTL; id += gridDim.x) {
    int mt, nt;
    tile_of(id, NT * MTL, NT, mt, nt);
    f32x4 acc[8][4];
    ZERO_ACC2(acc, 8, 4);
    gemm_dma<8, 4, true>(acc, merged + (size_t)mt * 256 * D, D, Wo + (size_t)nt * 128 * D, D, D, smem);
    {
      const int te = otid(), fr = te & 15, fq = (te >> 4) & 3, wm = te >> 7, wn = (te >> 6) & 1;
#pragma unroll
      for (int m = 0; m < 8; m++)
#pragma unroll
        for (int nn = 0; nn < 4; nn++) {
          const size_t off = (size_t)(mt * 256 + wm * 128 + m * 16 + fr) * D + nt * 128 + wn * 64 + nn * 16 + fq * 4;
          f32x4 xi = *(const f32x4*)(xin + off);
          *(f32x4*)(xout + off) = xi + acc[m][nn];
        }
    }
  }
}

#define XB_TMO 128
#define XB_XCNT(j) (256 + 64 * (j))
#define XB_XSUB(j) (1280 + 64 * (j))
#define XB_XGEN(j) (2304 + 64 * (j))
#define XB_TOP 3328
#define XB_TOPGEN 3392
#define XCD_BAR_WORDS 3456
#define XB_SPIN_CAP (1u << 20)
__device__ __forceinline__ unsigned xb_ld(unsigned* p) { return __hip_atomic_load(p, __ATOMIC_RELAXED, __HIP_MEMORY_SCOPE_AGENT); }
__device__ __forceinline__ unsigned xb_add(unsigned* p, unsigned v) {
  return __hip_atomic_fetch_add(p, v, __ATOMIC_RELAXED, __HIP_MEMORY_SCOPE_AGENT);
}
__device__ __forceinline__ unsigned xb_xcc_id() { return (unsigned)__builtin_amdgcn_s_getreg((3 << 11) | 20) & 0xFu; }
#define XB_SPIN(cond, bar)                                                      \
  do {                                                                          \
    unsigned _sp = 0;                                                           \
    while (cond) {                                                              \
      __builtin_amdgcn_s_sleep(1);                                              \
      if ((++_sp & 255u) == 0u) {                                               \
        if (xb_ld(&(bar)[XB_TMO])) break;                                       \
        if (_sp > XB_SPIN_CAP) { atomicAdd(&(bar)[XB_TMO], 1u); break; }        \
      }                                                                         \
    }                                                                           \
  } while (0)
struct XcdBarrier { unsigned* bar; };
__device__ __forceinline__ XcdBarrier xcd_barrier_post(unsigned* bar) {
  XcdBarrier b; b.bar = bar;
  if (threadIdx.x == 0) (void)xb_add(&bar[XB_XCNT(xb_xcc_id())], 1u);
  return b;
}
__device__ __forceinline__ void xcd_barrier_complete(unsigned* bar, unsigned x, unsigned& nloc, unsigned& nx) {
  const unsigned G = gridDim.x * gridDim.y * gridDim.z;
  unsigned sum, cnt, mine, sp = 0u;
  for (;;) {
    sum = 0u; cnt = 0u; mine = 0u;
#pragma unroll
    for (unsigned j = 0; j < 16; ++j) {
      const unsigned c = xb_ld(&bar[XB_XCNT(j)]);
      sum += c; cnt += (c > 0u) ? 1u : 0u; mine = (j == x) ? c : mine;
    }
    if (sum == G) break;
    __builtin_amdgcn_s_sleep(1);
    if ((++sp & 255u) == 0u) {
      if (xb_ld(&bar[XB_TMO])) break;
      if (sp > XB_SPIN_CAP) { atomicAdd(&bar[XB_TMO], 1u); break; }
    }
  }
  nloc = mine > 0u ? mine : 1u; nx = cnt > 0u ? cnt : 1u;
}
__device__ __forceinline__ void xcd_barrier(const XcdBarrier& b) {
  asm volatile("s_waitcnt vmcnt(0)" ::: "memory");
  __syncthreads();
  if (threadIdx.x == 0) {
    unsigned* bar = b.bar;
    __builtin_amdgcn_s_waitcnt(0);
    volatile LAS unsigned* st = (volatile LAS unsigned*)&g_xb_words;
    const unsigned bx = xb_xcc_id();
    unsigned nloc = st[0], nx = st[1];
    if (nloc == 0u) { xcd_barrier_complete(bar, bx, nloc, nx); st[0] = nloc; st[1] = nx; }
    const unsigned old = xb_add(&bar[XB_XSUB(bx)], 1u);
    const unsigned gen = old / nloc;
    if (old + 1u == (gen + 1u) * nloc) {
      __builtin_amdgcn_fence(__ATOMIC_RELEASE, "agent");
      asm volatile("s_waitcnt vmcnt(0)" ::: "memory");
      const unsigned og = xb_add(&bar[XB_TOP], 1u);
      const unsigned tg = og / nx;
      if (og + 1u == (tg + 1u) * nx) xb_add(&bar[XB_TOPGEN], 1u);
      else XB_SPIN(xb_ld(&bar[XB_TOPGEN]) == tg, bar);
      __builtin_amdgcn_fence(__ATOMIC_ACQUIRE, "agent");
      xb_add(&bar[XB_XGEN(bx)], 1u);
      asm volatile("s_waitcnt vmcnt(0)" ::: "memory");
    } else {
      XB_SPIN(xb_ld(&bar[XB_XGEN(bx)]) == gen, bar);
      __builtin_amdgcn_fence(__ATOMIC_ACQUIRE, "agent");
      asm volatile("s_waitcnt vmcnt(0)" ::: "memory");
    }
  }
  __syncthreads();
}

__global__ void __launch_bounds__(256, 2) mega(Params p) {
  cg::grid_group grid = cg::this_grid();
  extern __shared__ __attribute__((aligned(16))) char smem[];
  if (threadIdx.x == 0) g_xb_words = make_uint4(0u, 0u, 0u, 0u);
  __syncthreads();
  XcdBarrier xb = xcd_barrier_post(p.bar);
  if (p.use_cg) grid.sync();
#ifndef DUP
#define DUP 0
#endif
  phase_W(p, smem);
  xcd_barrier(xb);
  if (DUP == 6) { phase_W(p, smem); xcd_barrier(xb); }
  for (int l = 0; l < DEPTH; l++) {
    for (int ps = 0; ps < NPASS; ps++) {
      const float* xin = (l == 0 ? p.x : p.out) + (size_t)ps * TH * D;
      float* xout = p.out + (size_t)ps * TH * D;
      phase_R(xin, p.norm_g + l * D, p.hbuf);
      xcd_barrier(xb);
      if (DUP == 9) { phase_R(xin, p.norm_g + l * D, p.hbuf); xcd_barrier(xb); }
      if (DUP == 10) { xcd_barrier(xb); xcd_barrier(xb); xcd_barrier(xb); xcd_barrier(xb); xcd_barrier(xb); xcd_barrier(xb); xcd_barrier(xb); xcd_barrier(xb); }
      phase_G1(p, l, smem);
      xcd_barrier(xb);
      if (DUP == 1) { phase_G1(p, l, smem); xcd_barrier(xb); }
      phase_P2(p, l, smem);
      xcd_barrier(xb);
      if (DUP == 4) { for (int item = blockIdx.x; item < NCHK; item += gridDim.x) dn_prep_item(p, l, item, smem); xcd_barrier(xb); }
      if (DUP >= 80 && DUP < 90) { for (int it = blockIdx.x; it < N_ML; it += gridDim.x) ml_scan_item(p, l, it, smem, DUP - 80); xcd_barrier(xb); }
      phase_M(p, l, p.ctr + (l * NPASS + ps) * 8, smem);
      xcd_barrier(xb);
      if (DUP == 3) { phase_M(p, l, p.ctr + 64 + (l * NPASS + ps) * 8, smem); xcd_barrier(xb); }
      if (DUP == 7) { for (int it = blockIdx.x; it < N_DN; it += gridDim.x) dn_scan_item(p, it, smem); xcd_barrier(xb); }
      if (DUP == 8) { for (int it = blockIdx.x; it < N_ML; it += gridDim.x) ml_scan_item(p, l, it, smem); xcd_barrier(xb); }
      if (DUP == 5) {
        for (int it = blockIdx.x; it < N_DN + N_ML; it += gridDim.x) {
          if (it < N_DN) dn_scan_item(p, it, smem); else ml_scan_item(p, l, it - N_DN, smem);
        }
        xcd_barrier(xb);
      }
      phase_F1(p, l);
      xcd_barrier(xb);
      phase_F3(p, l, smem);
      xcd_barrier(xb);
      if (DUP == 2) { phase_F3(p, l, smem); xcd_barrier(xb); }
      phase_F4(p, l, xin, xout, smem);
      xcd_barrier(xb);
    }
  }
}

extern "C" void kernel_launch(void* const* d_in, const int* in_sizes, int n_in, void* d_out, int out_size,
                              void* d_ws, size_t ws_size, hipStream_t stream) {
  static int grid_blocks = 0;
  if (!grid_blocks) {
    (void)hipFuncSetAttribute((const void*)mega, hipFuncAttributeMaxDynamicSharedMemorySize, (int)LDS_BYTES);
    int dev = 0, cus = 0, per_cu = 0;
    (void)hipGetDevice(&dev);
    (void)hipDeviceGetAttribute(&cus, hipDeviceAttributeMultiprocessorCount, dev);
    (void)hipOccupancyMaxActiveBlocksPerMultiprocessor(&per_cu, mega, 256, LDS_BYTES);
    if (per_cu > 2) per_cu = 2;
    grid_blocks = cus * per_cu;
  }
  Params p{};
  const float* const* in = (const float* const*)d_in;
  p.x = in[0]; p.norm_g = in[1]; p.w_in = in[2]; p.conv_a = in[3]; p.dn_a_log = in[4]; p.dn_dt_bias = in[5];
  p.dn_norm_g = in[6]; p.na_q_norm = in[7]; p.na_k_norm = in[8]; p.na_rpb = in[9]; p.ga_q_norm = in[10];
  p.ga_k_norm = in[11]; p.ml_i_bias = in[12]; p.ml_f_bias = in[13]; p.ml_norm_g = in[14]; p.w_branch = in[15];
  p.w_out = in[16];
  p.out = (float*)d_out;
  char* ws = (char*)d_ws;
  size_t off = 0;
  auto take = [&](size_t bytes) { char* r = ws + off; off += (bytes + 255) & ~(size_t)255; return r; };
  p.ctr = (int*)take(1024);
  p.bar = (unsigned*)take(XCD_BAR_WORDS * 4);
  p.use_cg = 0; p.pad = 0;
  p.WinT = (u16*)take((size_t)DEPTH * NWIN * D * 2);
  p.WbT = (u16*)take((size_t)DEPTH * 4 * D * 512 * 2);
  p.WoT = (u16*)take((size_t)DEPTH * D * D * 2);
  p.hbuf = (u16*)take((size_t)TH * D * 2);
  p.Aqkv = (u16*)take((size_t)TH * 1536 * 2);
  p.Bqkv = (u16*)take((size_t)TH * 1024 * 2);
  p.Cqkv = (u16*)take((size_t)TH * 768 * 2);
  p.Dqkv = (u16*)take((size_t)TH * 1024 * 2);
  p.Z = (u16*)take((size_t)TH * 2560 * 2);
  p.Sm = (float*)take((size_t)TH * 32 * 4);
  p.qkvc = (u16*)take((size_t)TH * 1536 * 2);
  p.TP = (u16*)take((size_t)NCHK * 2 * 2 * 4096 * 2);
  p.KdT = (u16*)take((size_t)NCHK * 2 * 8192 * 2);
  p.vecs = (float*)take((size_t)NCHK * 2 * 144 * 4);
  p.MLhb = (u16*)take((size_t)TH * 512 * 2);
  p.Bo = (u16*)take((size_t)TH * 512 * 2);
  p.Co = (u16*)take((size_t)TH * 512 * 2);
  p.VtB = (u16*)take((size_t)TH * 512 * 2);
  p.VtC = (u16*)take((size_t)TH * 256 * 2);
  if (off > ws_size) return;
  (void)hipMemsetAsync(p.ctr, 0, 1024 + ((XCD_BAR_WORDS * 4 + 255) & ~255), stream);
  void* args[] = {&p};
  (void)hipLaunchCooperativeKernel((void*)mega, dim3(grid_blocks), dim3(256), args, LDS_BYTES, stream);
}
```

```cpp
#include <hip/hip_runtime.h>
#include <hip/hip_cooperative_groups.h>
namespace cg = cooperative_groups;

typedef unsigned short u16;
using bf16x8 = __attribute__((ext_vector_type(8))) short;
using f32x4 = __attribute__((ext_vector_type(4))) float;
using u32x4 = __attribute__((ext_vector_type(4))) unsigned;
using u32x2 = __attribute__((ext_vector_type(2))) unsigned;

constexpr int D = 1024, SEQ = 2048, BATCH = 16, DEPTH = 2, PROJW = 11808;
constexpr int NPASS = 2, BP = BATCH / NPASS, TH = BP * SEQ;
constexpr int NW1 = 7808;
constexpr int NWIN = NW1 + 4096;
constexpr float EPS = 1e-6f;
constexpr int NCHK = BP * 4 * 32;
constexpr size_t LDS_BYTES = 73728;

struct Params {
  const float* x; const float* norm_g; const float* w_in; const float* conv_a; const float* dn_a_log;
  const float* dn_dt_bias; const float* dn_norm_g; const float* na_q_norm; const float* na_k_norm;
  const float* na_rpb; const float* ga_q_norm; const float* ga_k_norm; const float* ml_i_bias;
  const float* ml_f_bias; const float* ml_norm_g; const float* w_branch; const float* w_out;
  float* out;
  u16* WinT; u16* WbT; u16* WoT;
  u16* hbuf; u16* Aqkv; u16* Bqkv; u16* Cqkv; u16* Dqkv; u16* Z; float* Sm; u16* qkvc;
  u16* TP; u16* KdT; float* vecs; u16* MLhb; u16* Bo; u16* Co; u16* VtB; u16* VtC; int* ctr; unsigned* bar; int use_cg; int pad;
};

#define LAS __attribute__((address_space(3)))
__shared__ uint4 g_xb_words;

typedef float f32x2_t __attribute__((ext_vector_type(2)));
typedef __bf16 bf16x2_t __attribute__((ext_vector_type(2)));
__device__ __forceinline__ unsigned pack2(float a, float b) {
  f32x2_t v = {a, b};
  return __builtin_bit_cast(unsigned, __builtin_convertvector(v, bf16x2_t));
}
__device__ __forceinline__ u16 f2bf(float f) { return __builtin_bit_cast(u16, (__bf16)f); }
__device__ __forceinline__ float bf2f(u16 h) { return __uint_as_float(((unsigned)h) << 16); }
__device__ __forceinline__ float wave_sum(float v) {
#pragma unroll
  for (int o = 32; o >= 1; o >>= 1) v += __shfl_xor(v, o);
  return v;
}
__device__ __forceinline__ float grp16_sum(float v) {
#pragma unroll
  for (int o = 8; o >= 1; o >>= 1) v += __shfl_xor(v, o);
  return v;
}
__device__ __forceinline__ float grp16_max(float v) {
#pragma unroll
  for (int o = 8; o >= 1; o >>= 1) v = fmaxf(v, __shfl_xor(v, o));
  return v;
}
__device__ __forceinline__ float sigmoidf_(float x) { return 1.f / (1.f + __expf(-x)); }
__device__ __forceinline__ float siluf_(float x) { return x / (1.f + __expf(-x)); }
__device__ __forceinline__ float softplusf_(float x) { return x > 20.f ? x : __logf(1.f + __expf(x)); }
__device__ __forceinline__ float logsigmoidf_(float x) { return fminf(x, 0.f) - __logf(1.f + __expf(-fabsf(x))); }
__device__ __forceinline__ int otid() {
  int t = threadIdx.x;
  asm volatile("" : "+v"(t));
  return t;
}
#define MFMA(a, b, c) __builtin_amdgcn_mfma_f32_16x16x32_bf16(a, b, c, 0, 0, 0)
__device__ __forceinline__ bf16x8 ldfrag(const u16* p) { return *reinterpret_cast<const bf16x8*>(p); }

__device__ __forceinline__ int win_src_col(int r) {
  if (r < 1536) return r;
  if (r < 3072) return 2064 + (r - 1536);
  if (r < 4096) return 4112 + (r - 3072);
  if (r < 5120) return 5648 + (r - 4096);
  if (r < 5632) return 1552 + (r - 5120);
  if (r < 6144) return 3600 + (r - 5632);
  if (r < 6656) return 5136 + (r - 6144);
  if (r < 7168) return 7200 + (r - 6656);
  if (r < 7680) return 6688 + (r - 7168);
  if (r < 7696) return 1536 + (r - 7680);
  if (r < 7712) return 6672 + (r - 7696);
  if (r < 7808) return -1;
  return 7712 + (r - 7808);
}
__device__ __forceinline__ void tr_tile(const float* __restrict__ src, int ldsrc, u16* __restrict__ dst, int K, int r0, int k0,
                        int mode, float* tile) {
  const int tid = otid();
  {
    int rr = tid & 63, kq = tid >> 6;
    int col = mode ? win_src_col(r0 + rr) : (r0 + rr);
    float v[16];
#pragma unroll
    for (int i = 0; i < 16; i++) v[i] = col >= 0 ? src[(size_t)(k0 + kq + 4 * i) * ldsrc + col] : 0.f;
#pragma unroll
    for (int i = 0; i < 16; i++) tile[(kq + 4 * i) * 65 + rr] = v[i];
  }
  __syncthreads();
  {
    int k2 = (tid & 31) * 2, rq = tid >> 5;
#pragma unroll
    for (int i = 0; i < 8; i++) {
      int r2 = rq + 8 * i;
      *(unsigned*)(dst + (size_t)(r0 + r2) * K + k0 + k2) = pack2(tile[k2 * 65 + r2], tile[(k2 + 1) * 65 + r2]);
    }
  }
  __syncthreads();
}
__device__ __forceinline__ void phase_W(const Params& p, char* smem) {
  float* tile = (float*)smem;
  constexpr int J_IN = (NWIN / 64) * 16, J_B = 4 * 16 * 8, J_O = 16 * 16, J_L = J_IN + J_B + J_O;
  for (int job = blockIdx.x; job < DEPTH * J_L; job += gridDim.x) {
    int l = job / J_L, j = job % J_L;
    if (j < J_IN) {
      int rt = j / 16, kt = j % 16;
      tr_tile(p.w_in + (size_t)l * D * PROJW, PROJW, p.WinT + (size_t)l * NWIN * D, D, rt * 64, kt * 64, 1, tile);
    } else if (j < J_IN + J_B) {
      j -= J_IN;
      int n = j / 128, q = j % 128, rt = q / 8, kt = q % 8;
      tr_tile(p.w_branch + ((size_t)l * 4 + n) * 512 * D, D, p.WbT + ((size_t)l * 4 + n) * D * 512, 512, rt * 64,
              kt * 64, 0, tile);
    } else {
      j -= J_IN + J_B;
      int rt = j / 16, kt = j % 16;
      tr_tile(p.w_out + (size_t)l * D * D, D, p.WoT + (size_t)l * D * D, D, rt * 64, kt * 64, 0, tile);
    }
  }
}

__device__ __forceinline__ void phase_R(const float* __restrict__ xin, const float* __restrict__ g, u16* __restrict__ hbuf) {
  const int tid_ = otid(), lane = tid_ & 63, gw = blockIdx.x * 4 + (tid_ >> 6), nw = gridDim.x * 4;
  for (int t = gw; t < TH; t += nw) {
    const float4* xr = (const float4*)(xin + (size_t)t * D);
    float4 v[4];
    float ss = 0.f;
#pragma unroll
    for (int i = 0; i < 4; i++) {
      v[i] = xr[i * 64 + lane];
      ss += v[i].x * v[i].x + v[i].y * v[i].y + v[i].z * v[i].z + v[i].w * v[i].w;
    }
    ss = wave_sum(ss);
    float sc = rsqrtf(ss * (1.f / D) + EPS);
#pragma unroll
    for (int i = 0; i < 4; i++) {
      float4 gg = ((const float4*)g)[i * 64 + lane];
      u32x2 o;
      o.x = pack2(v[i].x * sc * gg.x, v[i].y * sc * gg.y);
      o.y = pack2(v[i].z * sc * gg.z, v[i].w * sc * gg.w);
      *(u32x2*)(hbuf + (size_t)t * D + (i * 64 + lane) * 4) = o;
    }
  }
}

constexpr int LDSK = 72;
template <int NW>
__device__ __forceinline__ void gemm128(f32x4 (&acc)[4][NW], const u16* __restrict__ A, int lda,
                                        const u16* __restrict__ Bt, int ldb, int K, u16* sA, u16* sB) {
  const int tid = otid(), lane = tid & 63, w = tid >> 6, wm = w >> 1, wn = w & 1, fr = lane & 15, fq = lane >> 4;
  u32x4 ra[4], rb[NW];
#pragma unroll
  for (int i = 0; i < 4; i++) {
    int c = tid + i * 256, row = c >> 3, kc = c & 7;
    ra[i] = *(const u32x4*)(A + (size_t)row * lda + kc * 8);
    if (i < NW) rb[i] = *(const u32x4*)(Bt + (size_t)row * ldb + kc * 8);
  }
  for (int k0 = 0; k0 < K; k0 += 64) {
#pragma unroll
    for (int i = 0; i < 4; i++) {
      int c = tid + i * 256, row = c >> 3, kc = c & 7;
      *(u32x4*)(sA + row * LDSK + kc * 8) = ra[i];
      if (i < NW) *(u32x4*)(sB + row * LDSK + kc * 8) = rb[i];
    }
    __syncthreads();
    if (k0 + 64 < K) {
#pragma unroll
      for (int i = 0; i < 4; i++) {
        int c = tid + i * 256, row = c >> 3, kc = c & 7;
        ra[i] = *(const u32x4*)(A + (size_t)row * lda + k0 + 64 + kc * 8);
        if (i < NW) rb[i] = *(const u32x4*)(Bt + (size_t)row * ldb + k0 + 64 + kc * 8);
      }
    }
#pragma unroll
    for (int ks = 0; ks < 2; ks++) {
      bf16x8 af[4], bfr[NW];
#pragma unroll
      for (int m = 0; m < 4; m++) af[m] = ldfrag(sA + (wm * 64 + m * 16 + fr) * LDSK + ks * 32 + fq * 8);
#pragma unroll
      for (int n = 0; n < NW; n++) bfr[n] = ldfrag(sB + (wn * 16 * NW + n * 16 + fr) * LDSK + ks * 32 + fq * 8);
#pragma unroll
      for (int m = 0; m < 4; m++)
#pragma unroll
        for (int n = 0; n < NW; n++) acc[m][n] = MFMA(af[m], bfr[n], acc[m][n]);
    }
    __syncthreads();
  }
}
#define ZERO_ACC(a, NWV)                                                                                  \
  _Pragma("unroll") for (int m_ = 0; m_ < 4; m_++) _Pragma("unroll") for (int n_ = 0; n_ < NWV; n_++) a[m_][n_] = \
      f32x4{0.f, 0.f, 0.f, 0.f};

__device__ __forceinline__ int swz1k(int ob) { return ob ^ (((ob >> 9) & 1) << 5); }
template <int MW, int NW, bool SWAP = false>
__device__ __forceinline__ void gemm_dma(f32x4 (&acc)[MW][NW], const u16* __restrict__ A, int lda,
                                         const u16* __restrict__ Bt, int ldb, int K, char* smem) {
  constexpr int BM = 32 * MW, BN = 32 * NW, STG = (BM + BN) * 64, NLA = BM / 64, NLB = BN / 64, NL = NLA + NLB;
  const int tid = otid(), lane = tid & 63, w = tid >> 6, wm = w >> 1, wn = w & 1, fr = lane & 15, fq = lane >> 4;
  int offA[NLA], offB[NLB];
#pragma unroll
  for (int i = 0; i < NLA; i++) {
    int b = (tid + i * 256) * 16, st = b >> 10, sw = swz1k(b & 1023);
    offA[i] = (st * 16 + (sw >> 6)) * lda + ((sw & 63) >> 1);
  }
#pragma unroll
  for (int i = 0; i < NLB; i++) {
    int b = (tid + i * 256) * 16, st = b >> 10, sw = swz1k(b & 1023);
    offB[i] = (st * 16 + (sw >> 6)) * ldb + ((sw & 63) >> 1);
  }
  const int fo = swz1k(fr * 64 + fq * 16);
  const int nk = K >> 5;
  auto issue = [&](int t) {
    char* stg = smem + (t % 3) * STG;
#pragma unroll
    for (int i = 0; i < NLA; i++)
      __builtin_amdgcn_global_load_lds((const unsigned*)(A + offA[i] + t * 32), (unsigned*)(stg + (tid + i * 256) * 16), 16, 0,
                                       0);
#pragma unroll
    for (int i = 0; i < NLB; i++)
      __builtin_amdgcn_global_load_lds((const unsigned*)(Bt + offB[i] + t * 32),
                                       (unsigned*)(stg + BM * 64 + (tid + i * 256) * 16), 16, 0, 0);
  };
  issue(0);
  if (nk > 1) issue(1);
  for (int t = 0; t < nk; t++) {
    if (t + 1 < nk) asm volatile("s_waitcnt vmcnt(%0)" ::"n"(NL) : "memory");
    else asm volatile("s_waitcnt vmcnt(0)" ::: "memory");
    __builtin_amdgcn_s_barrier();
    const char* stg = smem + (t % 3) * STG;
    bf16x8 af[MW], bfr[NW];
#pragma unroll
    for (int m = 0; m < MW; m++) af[m] = *(const bf16x8*)(stg + (wm * MW + m) * 1024 + fo);
#pragma unroll
    for (int n = 0; n < NW; n++) bfr[n] = *(const bf16x8*)(stg + BM * 64 + (wn * NW + n) * 1024 + fo);
    if (t + 2 < nk) issue(t + 2);
    __builtin_amdgcn_s_setprio(1);
#pragma unroll
    for (int m = 0; m < MW; m++)
#pragma unroll
      for (int n = 0; n < NW; n++) acc[m][n] = SWAP ? MFMA(bfr[n], af[m], acc[m][n]) : MFMA(af[m], bfr[n], acc[m][n]);
    __builtin_amdgcn_s_setprio(0);
  }
  __builtin_amdgcn_s_barrier();
}
#define ZERO_ACC2(a, MWV, NWV)                                                                              \
  _Pragma("unroll") for (int m_ = 0; m_ < MWV; m_++) _Pragma("unroll") for (int n_ = 0; n_ < NWV; n_++) a[m_][n_] = \
      f32x4{0.f, 0.f, 0.f, 0.f};
__device__ __forceinline__ void tile_of(int id, int ntiles, int NT, int& mt, int& nt) {
  int q = (id & 7) * (ntiles >> 3) + (id >> 3);
  mt = (q / (NT * 8)) * 8 + (q & 7);
  nt = (q >> 3) % NT;
}

__device__ __forceinline__ void phase_G1(const Params& p, int l, char* smem) {
  const int tid = otid(), lane = tid & 63, w = tid >> 6, wm = w >> 1, wn = w & 1, fr = lane & 15, fq = lane >> 4;
  constexpr int NT = NW1 / 128, MTL = TH / 256;
  const u16* W = p.WinT + (size_t)l * NWIN * D;
  for (int id = blockIdx.x; id < NT * MTL; id += gridDim.x) {
    int mt, nt;
    tile_of(id, NT * MTL, NT, mt, nt);
    int n0 = nt * 128;
    u16* dst;
    int ldd, cb, act = 0, mode = 0;
    if (n0 < 1536) { dst = p.Aqkv; ldd = 1536; cb = n0; }
    else if (n0 < 3072) { dst = p.Bqkv; ldd = 1024; cb = n0 - 1536; mode = (cb < 1024) ? 1 : 3; }
    else if (n0 < 4096) { dst = p.Cqkv; ldd = 768; cb = n0 - 3072; mode = (cb < 768) ? 2 : 4; }
    else if (n0 < 5120) { dst = p.Dqkv; ldd = 1024; cb = n0 - 4096; }
    else if (n0 < 7680) { dst = p.Z; ldd = 2560; cb = n0 - 5120; act = (cb < 2048) ? 1 : 2; }
    else { dst = nullptr; ldd = 0; cb = 0; }
    f32x4 acc[8][4];
    ZERO_ACC2(acc, 8, 4);
    if (mode == 0) gemm_dma<8, 4, true>(acc, p.hbuf + (size_t)mt * 256 * D, D, W + (size_t)nt * 128 * D, D, D, smem);
    else gemm_dma<8, 4, false>(acc, p.hbuf + (size_t)mt * 256 * D, D, W + (size_t)nt * 128 * D, D, D, smem);
    if (mode == 1) {
      const int te = otid(), fr = te & 15, fq = (te >> 4) & 3, wm = te >> 7, wn = (te >> 6) & 1;
      const float* g = (cb < 512 ? p.na_q_norm : p.na_k_norm) + l * 64;
      float gv[4];
      const float qs = (cb < 512) ? 0.125f * 1.4426950408889634f : 1.f;
#pragma unroll
      for (int n = 0; n < 4; n++) gv[n] = g[n * 16 + fr] * qs;
#pragma unroll
      for (int m = 0; m < 8; m++)
#pragma unroll
        for (int j = 0; j < 4; j++) {
          float ss = 0.f;
#pragma unroll
          for (int n = 0; n < 4; n++) ss += acc[m][n][j] * acc[m][n][j];
          ss = grp16_sum(ss);
          float sc = rsqrtf(ss * (1.f / 64.f) + EPS);
          int row = mt * 256 + wm * 128 + m * 16 + fq * 4 + j;
#pragma unroll
          for (int n = 0; n < 4; n++)
            dst[(size_t)row * ldd + cb + wn * 64 + n * 16 + fr] = f2bf(acc[m][n][j] * sc * gv[n]);
        }
    } else if (mode == 2) {
      float* sX = (float*)smem;
      const int te = otid(), fr = te & 15, fq = (te >> 4) & 3, wm = te >> 7, wn = (te >> 6) & 1;
      const float* g = (cb < 512 ? p.ga_q_norm : p.ga_k_norm) + l * 128 + wn * 64;
      float gv[4];
      const float qs = (cb < 512) ? 0.08838834764831845f * 1.4426950408889634f : 1.f;
#pragma unroll
      for (int n = 0; n < 4; n++) gv[n] = g[n * 16 + fr] * qs;
#pragma unroll
      for (int m = 0; m < 8; m++)
#pragma unroll
        for (int j = 0; j < 4; j++) {
          float ss = 0.f;
#pragma unroll
          for (int n = 0; n < 4; n++) ss += acc[m][n][j] * acc[m][n][j];
          ss = grp16_sum(ss);
          if (fr == 0) sX[(wm * 128 + m * 16 + fq * 4 + j) * 2 + wn] = ss;
        }
      __syncthreads();
      float inv[2];
#pragma unroll
      for (int n = 0; n < 2; n++) inv[n] = exp2f(-(float)(n * 16 + fr) * (13.287712379549449f / 32.f));
#pragma unroll
      for (int m = 0; m < 8; m++)
#pragma unroll
        for (int j = 0; j < 4; j++) {
          int rl = wm * 128 + m * 16 + fq * 4 + j, row = mt * 256 + rl;
          float sc = rsqrtf((sX[rl * 2] + sX[rl * 2 + 1]) * (1.f / 128.f) + EPS);
          int ts = row & (SEQ - 1);
          float pos = wn ? (float)(ts & 63) : (float)(ts >> 6);
#pragma unroll
          for (int n = 0; n < 2; n++) {
            float ang = pos * inv[n];
            float kf = rintf(ang * 0.15915494309189535f);
            float rr = fmaf(-kf, 6.2831855f, ang);
            rr = fmaf(-kf, -1.7484555e-7f, rr);
            float sn = __sinf(rr), cs = __cosf(rr);
            float y1 = acc[m][n][j] * sc * gv[n], y2 = acc[m][n + 2][j] * sc * gv[n + 2];
            u16* o = dst + (size_t)row * ldd + cb + wn * 64 + n * 16 + fr;
            o[0] = f2bf(y1 * cs - y2 * sn);
            o[32] = f2bf(y1 * sn + y2 * cs);
          }
          __builtin_amdgcn_sched_barrier(0);
        }
      __syncthreads();
    } else if (mode >= 3) {
      const int te = otid(), fr = te & 15, fq = (te >> 4) & 3, wm = te >> 7, wn = (te >> 6) & 1;
      const int row0 = mt * 256 + wm * 128, bl = row0 >> 11;
      u16* vt;
      if (mode == 3) vt = p.VtB + ((size_t)(bl * 8 + ((cb - 1024) >> 6) + wn) * 64) * SEQ;
      else vt = p.VtC + ((size_t)(bl * 2 + ((cb - 768) >> 7)) * 128 + wn * 64) * SEQ;
#pragma unroll
      for (int m = 0; m < 8; m++)
#pragma unroll
        for (int n = 0; n < 4; n++) {
          u32x2 o;
          o.x = pack2(acc[m][n][0], acc[m][n][1]);
          o.y = pack2(acc[m][n][2], acc[m][n][3]);
          *(u32x2*)(vt + (size_t)(n * 16 + fr) * SEQ + ((row0 + m * 16 + fq * 4) & (SEQ - 1))) = o;
        }
    } else {
      const int te = otid(), fr = te & 15, fq = (te >> 4) & 3, wm = te >> 7, wn = (te >> 6) & 1;
#pragma unroll
      for (int m = 0; m < 8; m++)
#pragma unroll
        for (int n = 0; n < 4; n++) {
          const int row = mt * 256 + wm * 128 + m * 16 + fr, col0 = wn * 64 + n * 16 + fq * 4;
          f32x4 v = acc[m][n];
          if (dst) {
            if (act == 1) { v[0] = siluf_(v[0]); v[1] = siluf_(v[1]); v[2] = siluf_(v[2]); v[3] = siluf_(v[3]); }
            else if (act == 2) { v[0] = sigmoidf_(v[0]); v[1] = sigmoidf_(v[1]); v[2] = sigmoidf_(v[2]); v[3] = sigmoidf_(v[3]); }
            u32x2 o;
            o.x = pack2(v[0], v[1]);
            o.y = pack2(v[2], v[3]);
            *(u32x2*)(dst + (size_t)row * ldd + cb + col0) = o;
          } else if (col0 < 32) {
            *(f32x4*)(p.Sm + (size_t)row * 32 + col0) = v;
          }
        }
    }
  }
}

__device__ __forceinline__ void dn_prep_item(const Params& p, int l, int item, char* smem) {
  const int tid = otid(), lane = tid & 63, w = tid >> 6, fr = lane & 15, fq = lane >> 4;
  const int c = item & 31, h = (item >> 5) & 3, bl = item >> 7;
  u16* sQ = (u16*)smem;
  u16* sK = sQ + 64 * 136;
  float* sAm = (float*)(sK + 64 * 136);
  float* sBeta = sAm + 2 * 64 * 68;
  float* sGc = sBeta + 128;
  const size_t tbase = (size_t)bl * SEQ;
  const int t0 = c * 64;
  for (int part = 0; part < 3; part++) {
    const int ch = part * 512 + h * 128 + 2 * lane;
    float w0[5], w1[5];
#pragma unroll
    for (int j = 0; j < 5; j++) {
      w0[j] = p.conv_a[((size_t)l * 5 + j) * 1536 + ch];
      w1[j] = p.conv_a[((size_t)l * 5 + j) * 1536 + ch + 1];
    }
    const int rs = t0 + w * 16;
    unsigned xin[20];
#pragma unroll
    for (int r = 0; r < 20; r++) {
      int t = rs - 2 + r;
      xin[r] = (t >= 0 && t < SEQ) ? *(const unsigned*)(p.Aqkv + (tbase + t) * 1536 + ch) : 0u;
    }
    float y0[16], y1[16];
#pragma unroll
    for (int rr = 0; rr < 16; rr++) {
      float a0 = 0.f, a1 = 0.f;
#pragma unroll
      for (int j = 0; j < 5; j++) {
        a0 += w0[j] * bf2f((u16)(xin[rr + j] & 0xffff));
        a1 += w1[j] * bf2f((u16)(xin[rr + j] >> 16));
      }
      y0[rr] = siluf_(a0);
      y1[rr] = siluf_(a1);
    }
    if (part < 2) {
      float ss[16];
#pragma unroll
      for (int rr = 0; rr < 16; rr++) ss[rr] = y0[rr] * y0[rr] + y1[rr] * y1[rr];
#pragma unroll
      for (int o = 32; o >= 1; o >>= 1)
#pragma unroll
        for (int rr = 0; rr < 16; rr++) ss[rr] += __shfl_xor(ss[rr], o);
#pragma unroll
      for (int rr = 0; rr < 16; rr++) {
        float sc = rsqrtf(ss[rr] + EPS) * (part == 0 ? 0.08838834764831845f : 1.f);
        unsigned pk = pack2(y0[rr] * sc, y1[rr] * sc);
        *(unsigned*)((part == 0 ? sQ : sK) + (w * 16 + rr) * 136 + 2 * lane) = pk;
        *(unsigned*)(p.qkvc + (tbase + rs + rr) * 1536 + ch) = pk;
      }
    } else {
#pragma unroll
      for (int rr = 0; rr < 16; rr++) *(unsigned*)(p.qkvc + (tbase + rs + rr) * 1536 + ch) = pack2(y0[rr], y1[rr]);
    }
  }
  if (w < 2) {
    const int d = w, ip = lane;
    const int t = t0 + (d ? 63 - ip : ip);
    float apre = p.Sm[(tbase + t) * 32 + d * 4 + h];
    float bpre = p.Sm[(tbase + t) * 32 + 8 + d * 4 + h];
    float g = -__expf(p.dn_a_log[l * 8 + d * 4 + h]) * softplusf_(apre + p.dn_dt_bias[l * 8 + d * 4 + h]);
    float beta = 1.f / (1.f + __expf(-bpre));
    float gc = g;
#pragma unroll
    for (int off = 1; off < 64; off <<= 1) {
      float v = __shfl_up(gc, off);
      if (lane >= off) gc += v;
    }
    sBeta[d * 64 + ip] = beta;
    sGc[d * 64 + ip] = gc;
  }
  __syncthreads();
  {
    f32x4 akk[4], aqk[4];
#pragma unroll
    for (int n = 0; n < 4; n++) { akk[n] = f32x4{0, 0, 0, 0}; aqk[n] = f32x4{0, 0, 0, 0}; }
#pragma unroll
    for (int ks = 0; ks < 4; ks++) {
      bf16x8 fk = ldfrag(sK + (16 * w + fr) * 136 + ks * 32 + fq * 8);
      bf16x8 fqv = ldfrag(sQ + (16 * w + fr) * 136 + ks * 32 + fq * 8);
#pragma unroll
      for (int n = 0; n < 4; n++) {
        bf16x8 fb = ldfrag(sK + (n * 16 + fr) * 136 + ks * 32 + fq * 8);
        akk[n] = MFMA(fk, fb, akk[n]);
        aqk[n] = MFMA(fqv, fb, aqk[n]);
      }
    }
#pragma unroll
    for (int d = 0; d < 2; d++) {
      u16* Pg = p.TP + ((size_t)(item * 2 + d) * 2 + 1) * 4096;
#pragma unroll
      for (int n = 0; n < 4; n++)
#pragma unroll
        for (int j = 0; j < 4; j++) {
          int i = 16 * w + fq * 4 + j, jj = n * 16 + fr;
          int ip = d ? 63 - i : i, jp = d ? 63 - jj : jj;
          float e = (jp <= ip) ? __expf(sGc[d * 64 + ip] - sGc[d * 64 + jp]) : 0.f;
          float av = (jp < ip) ? sBeta[d * 64 + ip] * akk[n][j] * e : 0.f;
          sAm[(d * 64 + ip) * 68 + jp] = av;
          Pg[ip * 64 + jp] = f2bf(aqk[n][j] * e);
        }
    }
  }
  __syncthreads();
  {
#pragma unroll
    for (int d = 0; d < 2; d++) {
      int jp = lane, j = d ? 63 - jp : jp;
      float e = __expf(sGc[d * 64 + 63] - sGc[d * 64 + jp]);
      u16* Kg = p.KdT + (size_t)(item * 2 + d) * 8192;
#pragma unroll
      for (int c8 = 0; c8 < 4; c8++) {
        const int dk0 = w * 32 + c8 * 8;
        u32x4 kv = *(const u32x4*)(sK + j * 136 + dk0);
#pragma unroll
        for (int e2 = 0; e2 < 4; e2++) {
          Kg[(dk0 + 2 * e2) * 64 + jp] = f2bf(bf2f((u16)(kv[e2] & 0xffff)) * e);
          Kg[(dk0 + 2 * e2 + 1) * 64 + jp] = f2bf(bf2f((u16)(kv[e2] >> 16)) * e);
        }
      }
    }
    if (w >= 2) {
      int d = w - 2;
      float* vb = p.vecs + (size_t)(item * 2 + d) * 144;
      vb[lane] = sBeta[d * 64 + lane];
      vb[64 + lane] = __expf(sGc[d * 64 + lane]);
      if (lane == 0) vb[128] = __expf(sGc[d * 64 + 63]);
    }
  }
  if (w < 2) {
    const int d = w;
    const float* Am = sAm + d * 64 * 68;
    int cc = lane;
    asm volatile("" : "+v"(cc));
    float x[64];
#pragma unroll
    for (int i = 0; i < 64; i++) {
      float s = (i == cc) ? 1.f : 0.f;
#pragma unroll
      for (int j = 0; j < i; j++) s -= Am[i * 68 + j] * x[j];
      x[i] = s;
      __builtin_amdgcn_sched_barrier(0);
    }
    u16* Tg = p.TP + ((size_t)(item * 2 + d) * 2 + 0) * 4096;
#pragma unroll
    for (int i = 0; i < 64; i++) Tg[i * 64 + cc] = f2bf(x[i]);
  }
  __syncthreads();
}

__device__ __forceinline__ void phase_P2(const Params& p, int l, char* smem) {
  for (int item = blockIdx.x; item < NCHK; item += gridDim.x) dn_prep_item(p, l, item, smem);
}

__device__ __forceinline__ void lds_barrier() { asm volatile("s_waitcnt lgkmcnt(0)\n\ts_barrier" ::: "memory"); }
struct DnStep {
  bf16x8 ka[4], ta[2];
  float v[2][4], beta[4], egc[4], gtot;
};
struct DnLate {
  bf16x8 qa[4], pa[2], kd[2][2];
};
__device__ __forceinline__ void dn_load(DnStep& s, const Params& p, int bl, int h, int d, int sl, int cn, int w,
                                        int fr, int fq) {
  const int c = d ? 31 - cn : cn;
  const int pd = (((bl * 4 + h) * 32 + c) * 2 + d);
  const u16* Tg = p.TP + (size_t)pd * 8192;
  const float* vb = p.vecs + (size_t)pd * 144;
  const size_t tb = (size_t)bl * SEQ + c * 64;
  const int ipA = 16 * w + fr;
  const u16* krow = p.qkvc + (tb + (d ? 63 - ipA : ipA)) * 1536 + 512 + h * 128;
#pragma unroll
  for (int ks = 0; ks < 4; ks++) s.ka[ks] = ldfrag(krow + ks * 32 + fq * 8);
#pragma unroll
  for (int ks = 0; ks < 2; ks++) s.ta[ks] = ldfrag(Tg + (16 * w + fr) * 64 + ks * 32 + fq * 8);
#pragma unroll
  for (int j = 0; j < 4; j++) {
    int ip = 16 * w + fq * 4 + j;
    s.beta[j] = vb[ip];
    s.egc[j] = vb[64 + ip];
    size_t t = tb + (d ? 63 - ip : ip);
#pragma unroll
    for (int n = 0; n < 2; n++) s.v[n][j] = bf2f(p.qkvc[t * 1536 + 1024 + h * 128 + sl * 32 + n * 16 + fr]);
  }
  s.gtot = vb[128];
}
__device__ __forceinline__ void dn_load_q(DnLate& s, const Params& p, int bl, int h, int d, int cn, int w, int fr,
                                          int fq) {
  const int c = d ? 31 - cn : cn;
  const size_t tb = (size_t)bl * SEQ + c * 64;
  const int ipA = 16 * w + fr;
  const u16* qrow = p.qkvc + (tb + (d ? 63 - ipA : ipA)) * 1536 + h * 128;
#pragma unroll
  for (int ks = 0; ks < 4; ks++) s.qa[ks] = ldfrag(qrow + ks * 32 + fq * 8);
}
__device__ __forceinline__ void dn_load_pk(DnLate& s, const Params& p, int bl, int h, int d, int cn, int w, int fr,
                                           int fq) {
  const int c = d ? 31 - cn : cn;
  const int pd = (((bl * 4 + h) * 32 + c) * 2 + d);
  const u16* Pg = p.TP + (size_t)pd * 8192 + 4096;
  const u16* Kg = p.KdT + (size_t)pd * 8192;
#pragma unroll
  for (int ks = 0; ks < 2; ks++) {
    s.pa[ks] = ldfrag(Pg + (16 * w + fr) * 64 + ks * 32 + fq * 8);
#pragma unroll
    for (int m = 0; m < 2; m++) s.kd[m][ks] = ldfrag(Kg + (32 * w + m * 16 + fr) * 64 + ks * 32 + fq * 8);
  }
}
__device__ __forceinline__ void dn_step(const Params& p, int bl, const DnStep& cur, DnLate& lt, f32x4 (&Sacc)[2][2],
                                        u16* sST, u16* sRT, u16* sVnT, u16* og, size_t tbase, int cn, int d, int h,
                                        int sl, int w, int fr, int fq) {
  const int c = d ? 31 - cn : cn;
  const int cb = c * 64;
  const int cnn = cn + 1 < 32 ? cn + 1 : 31;
#pragma unroll
  for (int m = 0; m < 2; m++)
#pragma unroll
    for (int n = 0; n < 2; n++) {
      u32x2 o;
      o.x = pack2(Sacc[m][n][0], Sacc[m][n][1]);
      o.y = pack2(Sacc[m][n][2], Sacc[m][n][3]);
      *(u32x2*)(sST + (n * 16 + fr) * 136 + 32 * w + m * 16 + fq * 4) = o;
    }
  lds_barrier();
  f32x4 kS[2];
  kS[0] = kS[1] = f32x4{0, 0, 0, 0};
#pragma unroll
  for (int ks = 0; ks < 4; ks++) {
#pragma unroll
    for (int n = 0; n < 2; n++) kS[n] = MFMA(cur.ka[ks], ldfrag(sST + (n * 16 + fr) * 136 + ks * 32 + fq * 8), kS[n]);
  }
#pragma unroll
  for (int n = 0; n < 2; n++) {
    float r[4];
#pragma unroll
    for (int j = 0; j < 4; j++) r[j] = cur.beta[j] * (cur.v[n][j] - cur.egc[j] * kS[n][j]);
    u32x2 o;
    o.x = pack2(r[0], r[1]);
    o.y = pack2(r[2], r[3]);
    *(u32x2*)(sRT + (n * 16 + fr) * 72 + 16 * w + fq * 4) = o;
  }
  lds_barrier();
  f32x4 vn[2];
  vn[0] = vn[1] = f32x4{0, 0, 0, 0};
#pragma unroll
  for (int ks = 0; ks < 2; ks++)
#pragma unroll
    for (int n = 0; n < 2; n++) vn[n] = MFMA(cur.ta[ks], ldfrag(sRT + (n * 16 + fr) * 72 + ks * 32 + fq * 8), vn[n]);
  f32x4 qS[2];
  qS[0] = qS[1] = f32x4{0, 0, 0, 0};
#pragma unroll
  for (int ks = 0; ks < 4; ks++) {
#pragma unroll
    for (int n = 0; n < 2; n++) qS[n] = MFMA(lt.qa[ks], ldfrag(sST + (n * 16 + fr) * 136 + ks * 32 + fq * 8), qS[n]);
  }
  dn_load_q(lt, p, bl, h, d, cnn, w, fr, fq);
#pragma unroll
  for (int n = 0; n < 2; n++) {
    u32x2 o;
    o.x = pack2(vn[n][0], vn[n][1]);
    o.y = pack2(vn[n][2], vn[n][3]);
    *(u32x2*)(sVnT + (n * 16 + fr) * 72 + 16 * w + fq * 4) = o;
  }
  lds_barrier();
  f32x4 oo[2];
  oo[0] = oo[1] = f32x4{0, 0, 0, 0};
#pragma unroll
  for (int m = 0; m < 2; m++)
#pragma unroll
    for (int n = 0; n < 2; n++) Sacc[m][n] *= cur.gtot;
#pragma unroll
  for (int ks = 0; ks < 2; ks++) {
    bf16x8 vbf[2];
#pragma unroll
    for (int n = 0; n < 2; n++) vbf[n] = ldfrag(sVnT + (n * 16 + fr) * 72 + ks * 32 + fq * 8);
#pragma unroll
    for (int n = 0; n < 2; n++) oo[n] = MFMA(lt.pa[ks], vbf[n], oo[n]);
#pragma unroll
    for (int m = 0; m < 2; m++)
#pragma unroll
      for (int n = 0; n < 2; n++) Sacc[m][n] = MFMA(lt.kd[m][ks], vbf[n], Sacc[m][n]);
  }
#pragma unroll
  for (int n = 0; n < 2; n++)
#pragma unroll
    for (int j = 0; j < 4; j++) {
      int ip = 16 * w + fq * 4 + j;
      size_t t = tbase + cb + (d ? 63 - ip : ip);
      og[t * 512 + h * 128 + sl * 32 + n * 16 + fr] = f2bf(cur.egc[j] * qS[n][j] + oo[n][j]);
    }
  dn_load_pk(lt, p, bl, h, d, cnn, w, fr, fq);
}
__device__ __forceinline__ void dn_scan_item(const Params& p, int item, char* smem) {
  const int tid = otid(), lane = tid & 63, w = tid >> 6, fr = lane & 15, fq = lane >> 4;
  const int sl = item & 3, d = (item >> 2) & 1, h = (item >> 3) & 3, bl = item >> 5;
  u16* sST = (u16*)smem;
  u16* sRT = sST + 32 * 136;
  u16* sVnT = sRT + 32 * 72;
  const size_t tbase = (size_t)bl * SEQ;
  u16* og = p.Aqkv + (size_t)d * TH * 512;
  f32x4 Sacc[2][2];
#pragma unroll
  for (int m = 0; m < 2; m++)
#pragma unroll
    for (int n = 0; n < 2; n++) Sacc[m][n] = f32x4{0, 0, 0, 0};
  DnStep sa, sb;
  DnLate lt;
  dn_load(sa, p, bl, h, d, sl, 0, w, fr, fq);
  dn_load_q(lt, p, bl, h, d, 0, w, fr, fq);
  dn_load_pk(lt, p, bl, h, d, 0, w, fr, fq);
  __syncthreads();
  for (int cn = 0; cn < 32; cn += 2) {
    dn_load(sb, p, bl, h, d, sl, cn + 1, w, fr, fq);
    dn_step(p, bl, sa, lt, Sacc, sST, sRT, sVnT, og, tbase, cn, d, h, sl, w, fr, fq);
    if (cn + 2 < 32) dn_load(sa, p, bl, h, d, sl, cn + 2, w, fr, fq);
    dn_step(p, bl, sb, lt, Sacc, sST, sRT, sVnT, og, tbase, cn + 1, d, h, sl, w, fr, fq);
  }
  __syncthreads();
}

struct MlStep { u32x4 q[2], k[2], v; };
__device__ __forceinline__ void ml_load(MlStep& s, const Params& p, size_t tbase, int h, int d, int sl, int cn,
                                        int tid) {
  const int c = d ? 31 - cn : cn, cb = c * 64;
#pragma unroll
  for (int i = 0; i < 2; i++) {
    int cidx = tid + i * 256, ip = cidx >> 3, kc = cidx & 7;
    const size_t t = tbase + cb + (d ? 63 - ip : ip);
    s.q[i] = *(const u32x4*)(p.Dqkv + t * 1024 + h * 64 + kc * 8);
    s.k[i] = *(const u32x4*)(p.Dqkv + t * 1024 + 256 + h * 64 + kc * 8);
  }
  {
    int ip = tid >> 2, kc = tid & 3;
    const size_t t = tbase + cb + (d ? 63 - ip : ip);
    s.v = *(const u32x4*)(p.Dqkv + t * 1024 + 512 + h * 128 + sl * 32 + kc * 8);
  }
}
struct MlG { float ipre, fpre; };
__device__ __forceinline__ void ml_gload(MlG& g, const Params& p, size_t tbase, int h, int d, int cn, int lane) {
  const int c = d ? 31 - cn : cn, cb = c * 64, ip = lane;
  const size_t t = tbase + cb + (d ? 63 - ip : ip);
  g.ipre = p.Sm[t * 32 + 16 + d * 4 + h];
  g.fpre = p.Sm[t * 32 + 24 + d * 4 + h];
}
__device__ __forceinline__ void ml_gates(const MlG& g, int lane, float ib, float fb, float* sG) {
  const int ip = lane;
  float ig = g.ipre + ib;
  float lf = logsigmoidf_(g.fpre + fb);
  float b = lf;
#pragma unroll
  for (int off = 1; off < 64; off <<= 1) {
    float v = __shfl_up(b, off);
    if (lane >= off) b += v;
  }
  float a = ig - b;
  float pm = a;
#pragma unroll
  for (int off = 1; off < 64; off <<= 1) {
    float v = __shfl_up(pm, off);
    if (lane >= off) pm = fmaxf(pm, v);
  }
  const float pml = __shfl(pm, 63);
  sG[ip] = a;
  sG[64 + ip] = pm;
  sG[128 + ip] = b;
  sG[192 + ip] = __expf(a - pml);
  sG[256 + ip] = 0.125f * __expf(fminf(pml - pm, 80.f));
}
struct MlCtx {
  u16 *sQ, *sK, *sKT, *sS, *sVT, *sCT;
  float* sGall;
  u16* og;
  size_t tbase;
  float ib, fb;
  int h, d, sl, tid, lane, w, fr, fq, vf;
};
__device__ __forceinline__ void ml_step(const Params& p, const MlStep& cur, const MlG& gnext, f32x4 (&Cacc)[3],
                                        float& m_st, const MlCtx& x, int cn) {
  u16 *sQ = x.sQ, *sK = x.sK, *sKT = x.sKT, *sS = x.sS, *sVT = x.sVT, *sCT = x.sCT;
  float* sGall = x.sGall;
  u16* og = x.og;
  const size_t tbase = x.tbase;
  const float ib = x.ib, fb = x.fb;
  const int h = x.h, d = x.d, sl = x.sl, tid = x.tid, lane = x.lane, w = x.w, fr = x.fr, fq = x.fq;
    const int c = d ? 31 - cn : cn;
  const int cb = c * 64;
  const float* sA = sGall + (cn & 1) * 320;
  const float* sEa = sA + 192;
  const float* sEp = sA + 256;
  const float* sPm = sA + 64;
  const float* sBv = sA + 128;
  const float pm_last = sPm[63], b_last = sBv[63];
#pragma unroll
  for (int i = 0; i < 2; i++) {
    int cidx = tid + i * 256, ip = cidx >> 3, kc = cidx & 7;
    *(u32x4*)(sQ + ip * 72 + kc * 8) = cur.q[i];
    *(u32x4*)(sK + ip * 72 + kc * 8) = cur.k[i];
    u32x4 uk = cur.k[i];
    float wsc = sEa[ip] * 0.125f;
    u16* dst = sKT + (kc * 8) * 72 + ((((ip >> 3) ^ kc) & 7) * 8) + (ip & 7);
#pragma unroll
    for (int e = 0; e < 4; e++) {
      unsigned pk = pack2(bf2f((u16)(uk[e] & 0xffff)) * wsc, __uint_as_float(uk[e] & 0xffff0000u) * wsc);
      dst[(2 * e) * 72] = (u16)(pk & 0xffff);
      dst[(2 * e + 1) * 72] = (u16)(pk >> 16);
    }
  }
  {
    int ip = tid >> 2, kc = tid & 3;
    u32x4 uv = cur.v;
    u16* dst = sVT + (kc * 8) * 72 + ((((ip >> 3) ^ kc) & 7) * 8) + (ip & 7);
#pragma unroll
    for (int e = 0; e < 4; e++) {
      dst[(2 * e) * 72] = (u16)(uv[e] & 0xffff);
      dst[(2 * e + 1) * 72] = (u16)(uv[e] >> 16);
    }
  }
#pragma unroll
  for (int n = 0; n < 3; n++) {
    u32x2 o;
    o.x = pack2(Cacc[n][0], Cacc[n][1]);
    o.y = pack2(Cacc[n][2], Cacc[n][3]);
    *(u32x2*)(sCT + (n * 16 + fr) * 72 + 16 * w + fq * 4) = o;
  }
  lds_barrier();
  if (w == 3 && cn + 1 < 32) ml_gates(gnext, lane, ib, fb, sGall + ((cn + 1) & 1) * 320);
  {
    f32x4 s1[4];
#pragma unroll
    for (int n = 0; n < 4; n++) s1[n] = f32x4{0, 0, 0, 0};
#pragma unroll
    for (int ks = 0; ks < 2; ks++) {
      bf16x8 qa = ldfrag(sQ + (16 * w + fr) * 72 + ks * 32 + fq * 8);
#pragma unroll
      for (int n = 0; n < 4; n++) s1[n] = MFMA(qa, ldfrag(sK + (n * 16 + fr) * 72 + ks * 32 + fq * 8), s1[n]);
    }
    float eaj[4], epi[4];
#pragma unroll
    for (int n = 0; n < 4; n++) eaj[n] = sEa[n * 16 + fr];
#pragma unroll
    for (int j = 0; j < 4; j++) epi[j] = sEp[16 * w + fq * 4 + j];
#pragma unroll
    for (int n = 0; n < 4; n++)
#pragma unroll
      for (int j = 0; j < 4; j++) {
        int i = 16 * w + fq * 4 + j, jj = n * 16 + fr;
        float v = s1[n][j] * eaj[n] * epi[j];
        sS[i * 72 + jj] = f2bf(jj <= i ? v : 0.f);
      }
  }
  lds_barrier();
  f32x4 qC[3], SV[3], dC[3];
#pragma unroll
  for (int n = 0; n < 3; n++) qC[n] = SV[n] = dC[n] = f32x4{0, 0, 0, 0};
#pragma unroll
  for (int ks = 0; ks < 2; ks++) {
    bf16x8 qa = ldfrag(sQ + (16 * w + fr) * 72 + ks * 32 + fq * 8);
    bf16x8 sa = ldfrag(sS + (16 * w + fr) * 72 + ks * 32 + fq * 8);
    bf16x8 ka = ldfrag(sKT + (16 * w + fr) * 72 + ((((ks * 4 + fq) ^ (2 * w + (fr >> 3))) & 7) * 8));
#pragma unroll
    for (int n = 0; n < 3; n++) {
      bf16x8 cbf = ldfrag(sCT + (n * 16 + fr) * 72 + ks * 32 + fq * 8);
      bf16x8 vbf = ldfrag(sVT + (n * 16 + fr) * 72 + ((((ks * 4 + fq) ^ (2 * n + (fr >> 3))) & 7) * 8));
      qC[n] = MFMA(qa, cbf, qC[n]);
      SV[n] = MFMA(sa, vbf, SV[n]);
      dC[n] = MFMA(ka, vbf, dC[n]);
    }
  }
#pragma unroll
  for (int j = 0; j < 4; j++) {
    int i = 16 * w + fq * 4 + j;
    float pm_i = sPm[i], b_i = sBv[i];
    float rho = __expf(fminf(0.f, pm_i - m_st)), inter = __expf(fminf(0.f, m_st - pm_i));
    float qn = qC[2][j], rs = SV[2][j];
    float denom = inter * qn + rho * rs;
    float m_i = b_i + fmaxf(pm_i, m_st);
    float dn = 1.f / fmaxf(fabsf(denom), __expf(-m_i));
    size_t t = tbase + cb + (d ? 63 - i : i);
#pragma unroll
    for (int n = 0; n < 2; n++)
      if (!(x.vf & 1)) og[t * 512 + h * 128 + sl * 32 + n * 16 + fr] = f2bf((inter * qC[n][j] + rho * SV[n][j]) * dn);
      else asm volatile("" ::"v"((inter * qC[n][j] + rho * SV[n][j]) * dn));
  }
  {
    float sig = __expf(fminf(0.f, pm_last - m_st)), dec = __expf(fminf(0.f, m_st - pm_last));
#pragma unroll
    for (int n = 0; n < 3; n++) Cacc[n] = Cacc[n] * dec + dC[n] * sig;
    m_st = b_last + fmaxf(m_st, pm_last);
  }
  lds_barrier();
}
__device__ __forceinline__ void ml_scan_item(const Params& p, int l, int item, char* smem, int vf = 0) {
  MlCtx x;
  x.vf = vf;
  x.tid = otid(); x.lane = x.tid & 63; x.w = x.tid >> 6; x.fr = x.lane & 15; x.fq = x.lane >> 4;
  x.sl = item & 3; x.d = (item >> 2) & 1; x.h = (item >> 3) & 3;
  const int bl = item >> 5;
  x.sQ = (u16*)smem;
  x.sK = x.sQ + 64 * 72;
  x.sKT = x.sK + 64 * 72;
  x.sS = x.sKT + 64 * 72;
  x.sVT = x.sS + 64 * 72;
  x.sCT = x.sVT + 48 * 72;
  x.sGall = (float*)(x.sCT + 48 * 72);
  x.tbase = (size_t)bl * SEQ;
  x.og = x.d ? p.MLhb : (p.Aqkv + (size_t)2 * TH * 512);
  x.ib = p.ml_i_bias[l * 8 + x.d * 4 + x.h];
  x.fb = p.ml_f_bias[l * 8 + x.d * 4 + x.h];
  for (int e = x.tid; e < 16 * 72; e += 256) x.sVT[32 * 72 + e] = (u16)0x3f80;
  f32x4 Cacc[3];
  Cacc[0] = Cacc[1] = Cacc[2] = f32x4{0, 0, 0, 0};
  float m_st = 0.f;
  MlStep sa, sb;
  MlG g0, g1, g2;
  ml_load(sa, p, x.tbase, x.h, x.d, x.sl, 0, x.tid);
  ml_gload(g0, p, x.tbase, x.h, x.d, 0, x.lane);
  ml_gload(g1, p, x.tbase, x.h, x.d, 1, x.lane);
  if (x.w == 0) ml_gates(g0, x.lane, x.ib, x.fb, x.sGall);
  __syncthreads();
  for (int cn = 0; cn < 32; cn += 2) {
    if (!(vf & 2) || cn == 0) { ml_load(sb, p, x.tbase, x.h, x.d, x.sl, cn + 1, x.tid);
    ml_gload(g2, p, x.tbase, x.h, x.d, min(cn + 2, 31), x.lane); }
    ml_step(p, sa, g1, Cacc, m_st, x, cn);
    if (!(vf & 2)) { if (cn + 2 < 32) ml_load(sa, p, x.tbase, x.h, x.d, x.sl, cn + 2, x.tid);
    ml_gload(g1, p, x.tbase, x.h, x.d, min(cn + 3, 31), x.lane); }
    ml_step(p, sb, g2, Cacc, m_st, x, cn + 1);
  }
  __syncthreads();
}

template <int DH, int MT, bool NA>
__device__ __forceinline__ void attn_item(const u16* __restrict__ qbase, int ldq, const u16* __restrict__ kbase, int ldkv,
                                          const u16* __restrict__ vtbase, u16* __restrict__ obase, int ldo, int nkt,
                                          float scale, int r, int r0, const float* __restrict__ rpbh, char* smem) {
  const int tid = otid(), lane = tid & 63, w = tid >> 6, fr = lane & 15, fq = lane >> 4;
  constexpr int KS = DH / 32, ND = DH / 16, CPT = DH / 32, SPR = DH / 8;
  constexpr int NKT = NA ? 2 : 4, NTS = NA ? 1 : 2;
  const int kw = NA ? min(max(16 * w - 8, 0), 32) : 0;
  constexpr int KB = 64 * DH * 2, VB = DH * 128;
  char* sKb = smem;
  char* sVb = smem + 2 * KB;
  float* sBias = (float*)(smem + 2 * (KB + VB));
  if (NA)
    for (int e = tid; e < 15 * 31; e += 256) sBias[e] = rpbh[e];
  bf16x8 qf[MT][KS];
#pragma unroll
  for (int m = 0; m < MT; m++)
#pragma unroll
    for (int ks = 0; ks < KS; ks++)
      qf[m][ks] = ldfrag(qbase + (size_t)(w * 16 * MT + m * 16 + fr) * ldq + ks * 32 + fq * 8);
  f32x4 O[MT][ND];
  float mrow[MT], lrow[MT];
#pragma unroll
  for (int m = 0; m < MT; m++) {
#pragma unroll
    for (int n = 0; n < ND; n++) O[m][n] = f32x4{0, 0, 0, 0};
    mrow[m] = -1e30f;
    lrow[m] = 0.f;
  }
  const int koff = (tid / SPR) * ldkv + (((tid % SPR) ^ ((tid / SPR) & (SPR - 1))) * 8);
  const int voff = (tid >> 3) * SEQ + (((tid & 7) ^ ((tid >> 3) & 7)) * 8);
  auto gload = [&](int kt) {
    const u16* kg = kbase + (size_t)kt * 64 * ldkv;
    const u16* vg = vtbase + kt * 64;
    char* kdst = sKb + (kt & 1) * KB;
    char* vdst = sVb + (kt & 1) * VB;
#pragma unroll
    for (int i = 0; i < CPT; i++) {
      __builtin_amdgcn_global_load_lds((const unsigned*)(kg + koff + i * (256 / SPR) * ldkv),
                                       (unsigned*)(kdst + (tid + i * 256) * 16), 16, 0, 0);
      __builtin_amdgcn_global_load_lds((const unsigned*)(vg + voff + i * 32 * SEQ),
                                       (unsigned*)(vdst + (tid + i * 256) * 16), 16, 0, 0);
    }
  };
  gload(0);
  for (int kt = 0; kt < nkt; kt++) {
    const char* sKc = sKb + (kt & 1) * KB;
    const char* sVc = sVb + (kt & 1) * VB;
    asm volatile("s_waitcnt vmcnt(0)" ::: "memory");
    __builtin_amdgcn_s_barrier();
    if (kt + 1 < nkt) gload(kt + 1);
    f32x4 sT[MT][NKT];
#pragma unroll
    for (int m = 0; m < MT; m++)
#pragma unroll
      for (int n = 0; n < NKT; n++) sT[m][n] = f32x4{0, 0, 0, 0};
#pragma unroll
    for (int ks = 0; ks < KS; ks++) {
#pragma unroll
      for (int n = 0; n < NKT; n++) {
        const int krow = kw + n * 16 + fr;
        bf16x8 kb = *(const bf16x8*)(sKc + krow * (DH * 2) + (((ks * 4 + fq) ^ (krow & (SPR - 1))) * 16));
#pragma unroll
        for (int m = 0; m < MT; m++) sT[m][n] = MFMA(kb, qf[m][ks], sT[m][n]);
      }
    }
    bf16x8 pb[MT][NTS];
#pragma unroll
    for (int m = 0; m < MT; m++) {
      float mx = -1e30f;
#pragma unroll
      for (int n = 0; n < NKT; n++)
#pragma unroll
        for (int j = 0; j < 4; j++) {
          float v = sT[m][n][j];
          if (NA) {
            int cq = w * 16 * MT + m * 16 + fr, kc = kw + n * 16 + fq * 4 + j;
            int c0 = min(max(cq - 8, 0), 48);
            bool ok = (kc >= c0) && (kc < c0 + 16);
            v = ok ? fmaf(sBias[(r0 + kt - r + 7) * 31 + (kc - cq + 15)], 1.4426950408889634f, v) : -1e30f;
          }
          sT[m][n][j] = v;
          mx = fmaxf(mx, v);
        }
      mx = fmaxf(mx, __shfl_xor(mx, 16));
      mx = fmaxf(mx, __shfl_xor(mx, 32));
      const bool moved = mx > mrow[m] + 8.f;
      const float mnew = moved ? mx : mrow[m];
      if (__any(moved)) {
        float alpha = __builtin_amdgcn_exp2f(mrow[m] - mnew);
        lrow[m] *= alpha;
#pragma unroll
        for (int n = 0; n < ND; n++) O[m][n] *= alpha;
        mrow[m] = mnew;
      }
      float sum = 0.f;
#pragma unroll
      for (int n = 0; n < NKT; n++)
#pragma unroll
        for (int j = 0; j < 4; j++) {
          float pv = __builtin_amdgcn_exp2f(sT[m][n][j] - mnew);
          sT[m][n][j] = pv;
          sum += pv;
        }
      sum += __shfl_xor(sum, 16);
      sum += __shfl_xor(sum, 32);
      lrow[m] += sum;
#pragma unroll
      for (int t = 0; t < NTS; t++) {
        u32x4 pk;
        pk[0] = pack2(sT[m][2 * t][0], sT[m][2 * t][1]);
        pk[1] = pack2(sT[m][2 * t][2], sT[m][2 * t][3]);
        pk[2] = pack2(sT[m][2 * t + 1][0], sT[m][2 * t + 1][1]);
        pk[3] = pack2(sT[m][2 * t + 1][2], sT[m][2 * t + 1][3]);
        pb[m][t] = __builtin_bit_cast(bf16x8, pk);
      }
    }
#pragma unroll
    for (int t = 0; t < NTS; t++) {
#pragma unroll
      for (int n = 0; n < ND; n++) {
        const int k0 = kw + 32 * t + fq * 4;
        const char* vrow = sVc + (n * 16 + fr) * 128 + (k0 & 7) * 2;
        u32x2 lo = *(const u32x2*)(vrow + ((((k0 >> 3)) ^ (fr & 7)) & 7) * 16);
        u32x2 hi = *(const u32x2*)(vrow + ((((k0 >> 3) + 2) ^ (fr & 7)) & 7) * 16);
        u32x4 va = {lo[0], lo[1], hi[0], hi[1]};
        bf16x8 vaf = __builtin_bit_cast(bf16x8, va);
#pragma unroll
        for (int m = 0; m < MT; m++) O[m][n] = MFMA(vaf, pb[m][t], O[m][n]);
      }
    }
  }
  __builtin_amdgcn_s_barrier();
  const int tid2 = otid(), w2 = tid2 >> 6, fr2 = tid2 & 15, fq2 = (tid2 >> 4) & 3;
#pragma unroll
  for (int m = 0; m < MT; m++) {
    float il = 1.f / lrow[m];
    int row = w2 * 16 * MT + m * 16 + fr2;
#pragma unroll
    for (int n = 0; n < ND; n++) {
      u32x2* dp = (u32x2*)(obase + (size_t)row * ldo + n * 16 + fq2 * 4);
      u32x2 zz = *dp, o;
      o.x = pack2(O[m][n][0] * il * bf2f((u16)(zz.x & 0xffff)), O[m][n][1] * il * __uint_as_float(zz.x & 0xffff0000u));
      o.y = pack2(O[m][n][2] * il * bf2f((u16)(zz.y & 0xffff)), O[m][n][3] * il * __uint_as_float(zz.y & 0xffff0000u));
      *dp = o;
    }
  }
}

constexpr int N_DN = BP * 4 * 2 * 4, N_ML = N_DN, N_GA = BP * 4 * 16, N_NA = BP * 8 * 32;
__device__ __forceinline__ void phase_M(const Params& p, int l, int* ctr, char* smem) {
  const int xcd = blockIdx.x & 7;
  volatile LAS int* s_item_p = ((volatile LAS int*)&g_xb_words) + 2;
  constexpr int Q_DN = N_DN / 8, Q_ML = N_ML / 8, Q_GA = N_GA / 8, Q_NA = N_NA / 8;
  for (;;) {
    if (threadIdx.x == 0) *s_item_p = atomicAdd(ctr + xcd, 1);
    __syncthreads();
    int q = *s_item_p;
    __syncthreads();
    if (q >= Q_DN + Q_ML + Q_GA + Q_NA) break;
    if (q < Q_DN) q = q;
    else if (q < Q_DN + Q_GA / 2) q = Q_DN + Q_ML + (q - Q_DN);
    else if (q < Q_DN + Q_GA / 2 + Q_ML) q = Q_DN + (q - Q_DN - Q_GA / 2);
    else if (q < Q_DN + Q_ML + Q_GA) q = Q_DN + Q_ML + Q_GA / 2 + (q - Q_DN - Q_GA / 2 - Q_ML);
    if (q < Q_DN) {
      dn_scan_item(p, ((q >> 2) * 8 + xcd) * 4 + (q & 3), smem);
    } else if (q < Q_DN + Q_ML) {
      int u = q - Q_DN;
      ml_scan_item(p, l, ((u >> 2) * 8 + xcd) * 4 + (u & 3), smem);
    } else if (q < Q_DN + Q_ML + Q_GA) {
      int u = q - Q_DN - Q_ML;
      int grp = (u >> 5) * 8 + xcd, bl = grp >> 1, kvh = grp & 1, v = u & 31, hq = kvh * 2 + (v >> 4), qb = v & 15;
      u16* base = p.Cqkv + (size_t)bl * SEQ * 768;
      attn_item<128, 2, false>(base + (size_t)qb * 128 * 768 + hq * 128, 768, base + 512 + kvh * 128, 768,
                               p.VtC + (size_t)(bl * 2 + kvh) * 128 * SEQ,
                               p.Z + ((size_t)bl * SEQ + qb * 128) * 2560 + 1024 + hq * 128, 2560, 32, 0.08838834764831845f, 0, 0,
                               nullptr, smem);
    } else {
      int u = q - Q_DN - Q_ML - Q_GA;
      int grp = (u >> 5) * 8 + xcd, bl = grp >> 3, h = grp & 7, r = u & 31;
      int r0 = min(max(r - 4, 0), 24);
      u16* base = p.Bqkv + (size_t)bl * SEQ * 1024;
      attn_item<64, 1, true>(base + (size_t)r * 64 * 1024 + h * 64, 1024, base + (size_t)r0 * 64 * 1024 + 512 + h * 64, 1024,
                             p.VtB + (size_t)(bl * 8 + h) * 64 * SEQ + r0 * 64,
                             p.Z + ((size_t)bl * SEQ + r * 64) * 2560 + 512 + h * 64, 2560, 8, 0.125f, r, r0,
                             p.na_rpb + ((size_t)l * 8 + h) * 15 * 31, smem);
    }
  }
}

__device__ __forceinline__ void phase_F1(const Params& p, int l) {
  const int tid_ = otid(), lane = tid_ & 63, gw = blockIdx.x * 4 + (tid_ >> 6), nw = gridDim.x * 4;
  const u16* of = p.Aqkv;
  const u16* ob = p.Aqkv + (size_t)TH * 512;
  const u16* hf = p.Aqkv + (size_t)2 * TH * 512;
  const u16* hb = p.MLhb;
  for (int t = gw; t < TH; t += nw) {
    u16* z = p.Z + (size_t)t * 2560;
    const int e0 = lane * 8;
    float y[8];
    {
      u32x4 a = *(const u32x4*)(of + (size_t)t * 512 + e0), b = *(const u32x4*)(ob + (size_t)t * 512 + e0);
      u32x4 zz = *(const u32x4*)(z + e0);
      const u16 *pa = (const u16*)&a, *pb = (const u16*)&b, *pz = (const u16*)&zz;
      float ss = 0.f;
#pragma unroll
      for (int e = 0; e < 8; e++) { y[e] = bf2f(pa[e]) + bf2f(pb[e]); ss += y[e] * y[e]; }
      ss = grp16_sum(ss);
      float sc = rsqrtf(ss * (1.f / 128.f) + EPS);
      u32x4 ov;
      u16* o = (u16*)&ov;
#pragma unroll
      for (int e = 0; e < 8; e++) o[e] = f2bf(y[e] * sc * p.dn_norm_g[l * 128 + ((e0 + e) & 127)] * bf2f(pz[e]));
      *(u32x4*)(z + e0) = ov;
    }
    {
      u32x4 a = *(const u32x4*)(hf + (size_t)t * 512 + e0), b = *(const u32x4*)(hb + (size_t)t * 512 + e0);
      u32x4 zz = *(const u32x4*)(z + 1536 + e0), oz = *(const u32x4*)(z + 2048 + e0);
      const u16 *pa = (const u16*)&a, *pb = (const u16*)&b, *pz = (const u16*)&zz, *po = (const u16*)&oz;
      float ss = 0.f;
#pragma unroll
      for (int e = 0; e < 8; e++) { y[e] = bf2f(pa[e]) + bf2f(pb[e]); ss += y[e] * y[e]; }
      ss = grp16_sum(ss);
      float sc = rsqrtf(ss * (1.f / 128.f) + EPS);
      u32x4 ov;
      u16* o = (u16*)&ov;
#pragma unroll
      for (int e = 0; e < 8; e++)
        o[e] = f2bf(y[e] * sc * p.ml_norm_g[l * 128 + ((e0 + e) & 127)] * bf2f(pz[e]) * bf2f(po[e]));
      *(u32x4*)(z + 1536 + e0) = ov;
    }
  }
}

__device__ __forceinline__ void phase_F3(const Params& p, int l, char* smem) {
  const int tid = otid(), lane = tid & 63, w = tid >> 6, wm = w >> 1, wn = w & 1, fr = lane & 15, fq = lane >> 4;
  const u16* Wg = p.WinT + ((size_t)l * NWIN + NW1) * D;
  const u16* Wb = p.WbT + (size_t)l * 4 * D * 512;
  u16* merged = p.qkvc;
  constexpr int NT = 8, MTL = TH / 128;
  for (int id = blockIdx.x; id < NT * MTL; id += gridDim.x) {
    int mt, nt;
    tile_of(id, NT * MTL, NT, mt, nt);
    f32x4 accm[4][4];
    ZERO_ACC2(accm, 4, 4);
    for (int n = 0; n < 4; n++) {
      u32x2 gpk[4][4];
      {
        f32x4 accg[4][4];
        ZERO_ACC2(accg, 4, 4);
        gemm_dma<4, 4, true>(accg, p.hbuf + (size_t)mt * 128 * D, D, Wg + ((size_t)n * 1024 + nt * 128) * D, D, D, smem);
#pragma unroll
        for (int m = 0; m < 4; m++)
#pragma unroll
          for (int nn = 0; nn < 4; nn++) {
            float g0 = fmaxf(sigmoidf_(accg[m][nn][0]), 1e-6f), g1 = fmaxf(sigmoidf_(accg[m][nn][1]), 1e-6f);
            float g2 = fmaxf(sigmoidf_(accg[m][nn][2]), 1e-6f), g3 = fmaxf(sigmoidf_(accg[m][nn][3]), 1e-6f);
            gpk[m][nn].x = pack2(g0, g1);
            gpk[m][nn].y = pack2(g2, g3);
            accm[m][nn][0] = accm[m][nn][0] / bf2f((u16)(gpk[m][nn].x & 0xffff));
            accm[m][nn][1] = accm[m][nn][1] / bf2f((u16)(gpk[m][nn].x >> 16));
            accm[m][nn][2] = accm[m][nn][2] / bf2f((u16)(gpk[m][nn].y & 0xffff));
            accm[m][nn][3] = accm[m][nn][3] / bf2f((u16)(gpk[m][nn].y >> 16));
          }
      }
      gemm_dma<4, 4, true>(accm, p.Z + (size_t)mt * 128 * 2560 + n * 512, 2560, Wb + ((size_t)n * 1024 + nt * 128) * 512,
                           512, 512, smem);
#pragma unroll
      for (int m = 0; m < 4; m++)
#pragma unroll
        for (int nn = 0; nn < 4; nn++) {
          accm[m][nn][0] *= bf2f((u16)(gpk[m][nn].x & 0xffff));
          accm[m][nn][1] *= bf2f((u16)(gpk[m][nn].x >> 16));
          accm[m][nn][2] *= bf2f((u16)(gpk[m][nn].y & 0xffff));
          accm[m][nn][3] *= bf2f((u16)(gpk[m][nn].y >> 16));
        }
    }
    {
      const int te = otid(), fr = te & 15, fq = (te >> 4) & 3, wm = te >> 7, wn = (te >> 6) & 1;
#pragma unroll
      for (int m = 0; m < 4; m++)
#pragma unroll
        for (int nn = 0; nn < 4; nn++) {
          const int row = mt * 128 + wm * 64 + m * 16 + fr, col0 = nt * 128 + wn * 64 + nn * 16 + fq * 4;
          u32x2 o;
          o.x = pack2(accm[m][nn][0], accm[m][nn][1]);
          o.y = pack2(accm[m][nn][2], accm[m][nn][3]);
          *(u32x2*)(merged + (size_t)row * D + col0) = o;
        }
    }
  }
}

__device__ __forceinline__ void phase_F4(const Params& p, int l, const float* __restrict__ xin,
                                         float* __restrict__ xout, char* smem) {
  const int tid = otid(), lane = tid & 63, w = tid >> 6, wm = w >> 1, wn = w & 1, fr = lane & 15, fq = lane >> 4;
  const u16* Wo = p.WoT + (size_t)l * D * D;
  const u16* merged = p.qkvc;
  constexpr int NT = 8, MTL = TH / 256;
  for (int id = blockIdx.x; id < NT * MTL; id += gridDim.x) {
    int mt, nt;
    tile_of(id, NT * MTL, NT, mt, nt);
    f32x4 acc[8][4];
    ZERO_ACC2(acc, 8, 4);
    gemm_dma<8, 4, true>(acc, merged + (size_t)mt * 256 * D, D, Wo + (size_t)nt * 128 * D, D, D, smem);
    {
      const int te = otid(), fr = te & 15, fq = (te >> 4) & 3, wm = te >> 7, wn = (te >> 6) & 1;
#pragma unroll
      for (int m = 0; m < 8; m++)
#pragma unroll
        for (int nn = 0; nn < 4; nn++) {
          const size_t off = (size_t)(mt * 256 + wm * 128 + m * 16 + fr) * D + nt * 128 + wn * 64 + nn * 16 + fq * 4;
          f32x4 xi = *(const f32x4*)(xin + off);
          *(f32x4*)(xout + off) = xi + acc[m][nn];
        }
    }
  }
}

#define XB_TMO 128
#define XB_XCNT(j) (256 + 64 * (j))
#define XB_XSUB(j) (1280 + 64 * (j))
#define XB_XGEN(j) (2304 + 64 * (j))
#define XB_TOP 3328
#define XB_TOPGEN 3392
#define XCD_BAR_WORDS 3456
#define XB_SPIN_CAP (1u << 20)
__device__ __forceinline__ unsigned xb_ld(unsigned* p) { return __hip_atomic_load(p, __ATOMIC_RELAXED, __HIP_MEMORY_SCOPE_AGENT); }
__device__ __forceinline__ unsigned xb_add(unsigned* p, unsigned v) {
  return __hip_atomic_fetch_add(p, v, __ATOMIC_RELAXED, __HIP_MEMORY_SCOPE_AGENT);
}
__device__ __forceinline__ unsigned xb_xcc_id() { return (unsigned)__builtin_amdgcn_s_getreg((3 << 11) | 20) & 0xFu; }
#define XB_SPIN(cond, bar)                                                      \
  do {                                                                          \
    unsigned _sp = 0;                                                           \
    while (cond) {                                                              \
      __builtin_amdgcn_s_sleep(1);                                              \
      if ((++_sp & 255u) == 0u) {                                               \
        if (xb_ld(&(bar)[XB_TMO])) break;                                       \
        if (_sp > XB_SPIN_CAP) { atomicAdd(&(bar)[XB_TMO], 1u); break; }        \
      }                                                                         \
    }                                                                           \
  } while (0)
struct XcdBarrier { unsigned* bar; };
__device__ __forceinline__ XcdBarrier xcd_barrier_post(unsigned* bar) {
  XcdBarrier b; b.bar = bar;
  if (threadIdx.x == 0) (void)xb_add(&bar[XB_XCNT(xb_xcc_id())], 1u);
  return b;
}
__device__ __forceinline__ void xcd_barrier_complete(unsigned* bar, unsigned x, unsigned& nloc, unsigned& nx) {
  const unsigned G = gridDim.x * gridDim.y * gridDim.z;
  unsigned sum, cnt, mine, sp = 0u;
  for (;;) {
    sum = 0u; cnt = 0u; mine = 0u;
#pragma unroll
    for (unsigned j = 0; j < 16; ++j) {
      const unsigned c = xb_ld(&bar[XB_XCNT(j)]);
      sum += c; cnt += (c > 0u) ? 1u : 0u; mine = (j == x) ? c : mine;
    }
    if (sum == G) break;
    __builtin_amdgcn_s_sleep(1);
    if ((++sp & 255u) == 0u) {
      if (xb_ld(&bar[XB_TMO])) break;
      if (sp > XB_SPIN_CAP) { atomicAdd(&bar[XB_TMO], 1u); break; }
    }
  }
  nloc = mine > 0u ? mine : 1u; nx = cnt > 0u ? cnt : 1u;
}
__device__ __forceinline__ void xcd_barrier(const XcdBarrier& b) {
  asm volatile("s_waitcnt vmcnt(0)" ::: "memory");
  __syncthreads();
  if (threadIdx.x == 0) {
    unsigned* bar = b.bar;
    __builtin_amdgcn_s_waitcnt(0);
    volatile LAS unsigned* st = (volatile LAS unsigned*)&g_xb_words;
    const unsigned bx = xb_xcc_id();
    unsigned nloc = st[0], nx = st[1];
    if (nloc == 0u) { xcd_barrier_complete(bar, bx, nloc, nx); st[0] = nloc; st[1] = nx; }
    const unsigned old = xb_add(&bar[XB_XSUB(bx)], 1u);
    const unsigned gen = old / nloc;
    if (old + 1u == (gen + 1u) * nloc) {
      __builtin_amdgcn_fence(__ATOMIC_RELEASE, "agent");
      asm volatile("s_waitcnt vmcnt(0)" ::: "memory");
      const unsigned og = xb_add(&bar[XB_TOP], 1u);
      const unsigned tg = og / nx;
      if (og + 1u == (tg + 1u) * nx) xb_add(&bar[XB_TOPGEN], 1u);
      else XB_SPIN(xb_ld(&bar[XB_TOPGEN]) == tg, bar);
      __builtin_amdgcn_fence(__ATOMIC_ACQUIRE, "agent");
      xb_add(&bar[XB_XGEN(bx)], 1u);
      asm volatile("s_waitcnt vmcnt(0)" ::: "memory");
    } else {
      XB_SPIN(xb_ld(&bar[XB_XGEN(bx)]) == gen, bar);
      __builtin_amdgcn_fence(__ATOMIC_ACQUIRE, "agent");
      asm volatile("s_waitcnt vmcnt(0)" ::: "memory");
    }
  }
  __syncthreads();
}

__global__ void __launch_bounds__(256, 2) mega(Params p) {
  cg::grid_group grid = cg::this_grid();
  extern __shared__ __attribute__((aligned(16))) char smem[];
  if (threadIdx.x == 0) g_xb_words = make_uint4(0u, 0u, 0u, 0u);
  __syncthreads();
  XcdBarrier xb = xcd_barrier_post(p.bar);
  if (p.use_cg) grid.sync();
#ifndef DUP
#define DUP 0
#endif
  phase_W(p, smem);
  xcd_barrier(xb);
  if (DUP == 6) { phase_W(p, smem); xcd_barrier(xb); }
  for (int l = 0; l < DEPTH; l++) {
    for (int ps = 0; ps < NPASS; ps++) {
      const float* xin = (l == 0 ? p.x : p.out) + (size_t)ps * TH * D;
      float* xout = p.out + (size_t)ps * TH * D;
      phase_R(xin, p.norm_g + l * D, p.hbuf);
      xcd_barrier(xb);
      if (DUP == 9) { phase_R(xin, p.norm_g + l * D, p.hbuf); xcd_barrier(xb); }
      if (DUP == 10) { xcd_barrier(xb); xcd_barrier(xb); xcd_barrier(xb); xcd_barrier(xb); xcd_barrier(xb); xcd_barrier(xb); xcd_barrier(xb); xcd_barrier(xb); }
      phase_G1(p, l, smem);
      xcd_barrier(xb);
      if (DUP == 1) { phase_G1(p, l, smem); xcd_barrier(xb); }
      phase_P2(p, l, smem);
      xcd_barrier(xb);
      if (DUP == 4) { for (int item = blockIdx.x; item < NCHK; item += gridDim.x) dn_prep_item(p, l, item, smem); xcd_barrier(xb); }
      if (DUP >= 80 && DUP < 90) { for (int it = blockIdx.x; it < N_ML; it += gridDim.x) ml_scan_item(p, l, it, smem, DUP - 80); xcd_barrier(xb); }
      phase_M(p, l, p.ctr + (l * NPASS + ps) * 8, smem);
      xcd_barrier(xb);
      if (DUP == 3) { phase_M(p, l, p.ctr + 64 + (l * NPASS + ps) * 8, smem); xcd_barrier(xb); }
      if (DUP == 7) { for (int it = blockIdx.x; it < N_DN; it += gridDim.x) dn_scan_item(p, it, smem); xcd_barrier(xb); }
      if (DUP == 8) { for (int it = blockIdx.x; it < N_ML; it += gridDim.x) ml_scan_item(p, l, it, smem); xcd_barrier(xb); }
      if (DUP == 5) {
        for (int it = blockIdx.x; it < N_DN + N_ML; it += gridDim.x) {
          if (it < N_DN) dn_scan_item(p, it, smem); else ml_scan_item(p, l, it - N_DN, smem);
        }
        xcd_barrier(xb);
      }
      phase_F1(p, l);
      xcd_barrier(xb);
      phase_F3(p, l, smem);
      xcd_barrier(xb);
      if (DUP == 2) { phase_F3(p, l, smem); xcd_barrier(xb); }
      phase_F4(p, l, xin, xout, smem);
      xcd_barrier(xb);
    }
  }
}

extern "C" void kernel_launch(void* const* d_in, const int* in_sizes, int n_in, void* d_out, int out_size,
                              void* d_ws, size_t ws_size, hipStream_t stream) {
  static int grid_blocks = 0;
  if (!grid_blocks) {
    (void)hipFuncSetAttribute((const void*)mega, hipFuncAttributeMaxDynamicSharedMemorySize, (int)LDS_BYTES);
    int dev = 0, cus = 0, per_cu = 0;
    (void)hipGetDevice(&dev);
    (void)hipDeviceGetAttribute(&cus, hipDeviceAttributeMultiprocessorCount, dev);
    (void)hipOccupancyMaxActiveBlocksPerMultiprocessor(&per_cu, mega, 256, LDS_BYTES);
    if (per_cu > 2) per_cu = 2;
    grid_blocks = cus * per_cu;
  }
  Params p{};
  const float* const* in = (const float* const*)d_in;
  p.x = in[0]; p.norm_g = in[1]; p.w_in = in[2]; p.conv_a = in[3]; p.dn_a_log = in[4]; p.dn_dt_bias = in[5];
  p.dn_norm_g = in[6]; p.na_q_norm = in[7]; p.na_k_norm = in[8]; p.na_rpb = in[9]; p.ga_q_norm = in[10];
  p.ga_k_norm = in[11]; p.ml_i_bias = in[12]; p.ml_f_bias = in[13]; p.ml_norm_g = in[14]; p.w_branch = in[15];
  p.w_out = in[16];
  p.out = (float*)d_out;
  char* ws = (char*)d_ws;
  size_t off = 0;
  auto take = [&](size_t bytes) { char* r = ws + off; off += (bytes + 255) & ~(size_t)255; return r; };
  p.ctr = (int*)take(1024);
  p.bar = (unsigned*)take(XCD_BAR_WORDS * 4);
  p.use_cg = 0; p.pad = 0;
  p.WinT = (u16*)take((size_t)DEPTH * NWIN * D * 2);
  p.WbT = (u16*)take((size_t)DEPTH * 4 * D * 512 * 2);
  p.WoT = (u16*)take((size_t)DEPTH * D * D * 2);
  p.hbuf = (u16*)take((size_t)TH * D * 2);
  p.Aqkv = (u16*)take((size_t)TH * 1536 * 2);
  p.Bqkv = (u16*)take((size_t)TH * 1024 * 2);
  p.Cqkv = (u16*)take((size_t)TH * 768 * 2);
  p.Dqkv = (u16*)take((size_t)TH * 1024 * 2);
  p.Z = (u16*)take((size_t)TH * 2560 * 2);
  p.Sm = (float*)take((size_t)TH * 32 * 4);
  p.qkvc = (u16*)take((size_t)TH * 1536 * 2);
  p.TP = (u16*)take((size_t)NCHK * 2 * 2 * 4096 * 2);
  p.KdT = (u16*)take((size_t)NCHK * 2 * 8192 * 2);
  p.vecs = (float*)take((size_t)NCHK * 2 * 144 * 4);
  p.MLhb = (u16*)take((size_t)TH * 512 * 2);
  p.Bo = (u16*)take((size_t)TH * 512 * 2);
  p.Co = (u16*)take((size_t)TH * 512 * 2);
  p.VtB = (u16*)take((size_t)TH * 512 * 2);
  p.VtC = (u16*)take((size_t)TH * 256 * 2);
  if (off > ws_size) return;
  (void)hipMemsetAsync(p.ctr, 0, 1024 + ((XCD_BAR_WORDS * 4 + 255) & ~255), stream);
  void* args[] = {&p};
  (void)hipLaunchCooperativeKernel((void*)mega, dim3(grid_blocks), dim3(256), args, LDS_BYTES, stream);
}
```

```cpp
#include <hip/hip_runtime.h>
#include <hip/hip_cooperative_groups.h>
namespace cg = cooperative_groups;

typedef unsigned short u16;
using bf16x8 = __attribute__((ext_vector_type(8))) short;
using f32x4 = __attribute__((ext_vector_type(4))) float;
using u32x4 = __attribute__((ext_vector_type(4))) unsigned;
using u32x2 = __attribute__((ext_vector_type(2))) unsigned;

constexpr int D = 1024, SEQ = 2048, BATCH = 16, DEPTH = 2, PROJW = 11808;
constexpr int NPASS = 2, BP = BATCH / NPASS, TH = BP * SEQ;
constexpr int NW1 = 7808;
constexpr int NWIN = NW1 + 4096;
constexpr float EPS = 1e-6f;
constexpr int NCHK = BP * 4 * 32;
constexpr size_t LDS_BYTES = 73728;

struct Params {
  const float* x; const float* norm_g; const float* w_in; const float* conv_a; const float* dn_a_log;
  const float* dn_dt_bias; const float* dn_norm_g; const float* na_q_norm; const float* na_k_norm;
  const float* na_rpb; const float* ga_q_norm; const float* ga_k_norm; const float* ml_i_bias;
  const float* ml_f_bias; const float* ml_norm_g; const float* w_branch; const float* w_out;
  float* out;
  u16* WinT; u16* WbT; u16* WoT;
  u16* hbuf; u16* Aqkv; u16* Bqkv; u16* Cqkv; u16* Dqkv; u16* Z; float* Sm; u16* qkvc;
  u16* TP; u16* KdT; float* vecs; u16* MLhb; u16* Bo; u16* Co; u16* VtB; u16* VtC; int* ctr; unsigned* bar; int use_cg; int pad;
};

#define LAS __attribute__((address_space(3)))
__shared__ uint4 g_xb_words;

typedef float f32x2_t __attribute__((ext_vector_type(2)));
typedef __bf16 bf16x2_t __attribute__((ext_vector_type(2)));
__device__ __forceinline__ unsigned pack2(float a, float b) {
  f32x2_t v = {a, b};
  return __builtin_bit_cast(unsigned, __builtin_convertvector(v, bf16x2_t));
}
__device__ __forceinline__ u16 f2bf(float f) { return __builtin_bit_cast(u16, (__bf16)f); }
__device__ __forceinline__ float bf2f(u16 h) { return __uint_as_float(((unsigned)h) << 16); }
__device__ __forceinline__ float wave_sum(float v) {
#pragma unroll
  for (int o = 32; o >= 1; o >>= 1) v += __shfl_xor(v, o);
  return v;
}
__device__ __forceinline__ float grp16_sum(float v) {
#pragma unroll
  for (int o = 8; o >= 1; o >>= 1) v += __shfl_xor(v, o);
  return v;
}
__device__ __forceinline__ float grp16_max(float v) {
#pragma unroll
  for (int o = 8; o >= 1; o >>= 1) v = fmaxf(v, __shfl_xor(v, o));
  return v;
}
__device__ __forceinline__ float sigmoidf_(float x) { return 1.f / (1.f + __expf(-x)); }
__device__ __forceinline__ float siluf_(float x) { return x / (1.f + __expf(-x)); }
__device__ __forceinline__ float softplusf_(float x) { return x > 20.f ? x : __logf(1.f + __expf(x)); }
__device__ __forceinline__ float logsigmoidf_(float x) { return fminf(x, 0.f) - __logf(1.f + __expf(-fabsf(x))); }
__device__ __forceinline__ int otid() {
  int t = threadIdx.x;
  asm volatile("" : "+v"(t));
  return t;
}
#define MFMA(a, b, c) __builtin_amdgcn_mfma_f32_16x16x32_bf16(a, b, c, 0, 0, 0)
__device__ __forceinline__ bf16x8 ldfrag(const u16* p) { return *reinterpret_cast<const bf16x8*>(p); }

__device__ __forceinline__ int win_src_col(int r) {
  if (r < 1536) return r;
  if (r < 3072) return 2064 + (r - 1536);
  if (r < 4096) return 4112 + (r - 3072);
  if (r < 5120) return 5648 + (r - 4096);
  if (r < 5632) return 1552 + (r - 5120);
  if (r < 6144) return 3600 + (r - 5632);
  if (r < 6656) return 5136 + (r - 6144);
  if (r < 7168) return 7200 + (r - 6656);
  if (r < 7680) return 6688 + (r - 7168);
  if (r < 7696) return 1536 + (r - 7680);
  if (r < 7712) return 6672 + (r - 7696);
  if (r < 7808) return -1;
  return 7712 + (r - 7808);
}
__device__ __forceinline__ void tr_tile(const float* __restrict__ src, int ldsrc, u16* __restrict__ dst, int K, int r0, int k0,
                        int mode, float* tile) {
  const int tid = otid();
  {
    int rr = tid & 63, kq = tid >> 6;
    int col = mode ? win_src_col(r0 + rr) : (r0 + rr);
    float v[16];
#pragma unroll
    for (int i = 0; i < 16; i++) v[i] = col >= 0 ? src[(size_t)(k0 + kq + 4 * i) * ldsrc + col] : 0.f;
#pragma unroll
    for (int i = 0; i < 16; i++) tile[(kq + 4 * i) * 65 + rr] = v[i];
  }
  __syncthreads();
  {
    int k2 = (tid & 31) * 2, rq = tid >> 5;
#pragma unroll
    for (int i = 0; i < 8; i++) {
      int r2 = rq + 8 * i;
      *(unsigned*)(dst + (size_t)(r0 + r2) * K + k0 + k2) = pack2(tile[k2 * 65 + r2], tile[(k2 + 1) * 65 + r2]);
    }
  }
  __syncthreads();
}
__device__ __forceinline__ void phase_W(const Params& p, char* smem) {
  float* tile = (float*)smem;
  constexpr int J_IN = (NWIN / 64) * 16, J_B = 4 * 16 * 8, J_O = 16 * 16, J_L = J_IN + J_B + J_O;
  for (int job = blockIdx.x; job < DEPTH * J_L; job += gridDim.x) {
    int l = job / J_L, j = job % J_L;
    if (j < J_IN) {
      int rt = j / 16, kt = j % 16;
      tr_tile(p.w_in + (size_t)l * D * PROJW, PROJW, p.WinT + (size_t)l * NWIN * D, D, rt * 64, kt * 64, 1, tile);
    } else if (j < J_IN + J_B) {
      j -= J_IN;
      int n = j / 128, q = j % 128, rt = q / 8, kt = q % 8;
      tr_tile(p.w_branch + ((size_t)l * 4 + n) * 512 * D, D, p.WbT + ((size_t)l * 4 + n) * D * 512, 512, rt * 64,
              kt * 64, 0, tile);
    } else {
      j -= J_IN + J_B;
      int rt = j / 16, kt = j % 16;
      tr_tile(p.w_out + (size_t)l * D * D, D, p.WoT + (size_t)l * D * D, D, rt * 64, kt * 64, 0, tile);
    }
  }
}

__device__ __forceinline__ void phase_R(const float* __restrict__ xin, const float* __restrict__ g, u16* __restrict__ hbuf) {
  const int tid_ = otid(), lane = tid_ & 63, gw = blockIdx.x * 4 + (tid_ >> 6), nw = gridDim.x * 4;
  for (int t = gw; t < TH; t += nw) {
    const float4* xr = (const float4*)(xin + (size_t)t * D);
    float4 v[4];
    float ss = 0.f;
#pragma unroll
    for (int i = 0; i < 4; i++) {
      v[i] = xr[i * 64 + lane];
      ss += v[i].x * v[i].x + v[i].y * v[i].y + v[i].z * v[i].z + v[i].w * v[i].w;
    }
    ss = wave_sum(ss);
    float sc = rsqrtf(ss * (1.f / D) + EPS);
#pragma unroll
    for (int i = 0; i < 4; i++) {
      float4 gg = ((const float4*)g)[i * 64 + lane];
      u32x2 o;
      o.x = pack2(v[i].x * sc * gg.x, v[i].y * sc * gg.y);
      o.y = pack2(v[i].z * sc * gg.z, v[i].w * sc * gg.w);
      *(u32x2*)(hbuf + (size_t)t * D + (i * 64 + lane) * 4) = o;
    }
  }
}

constexpr int LDSK = 72;
template <int NW>
__device__ __forceinline__ void gemm128(f32x4 (&acc)[4][NW], const u16* __restrict__ A, int lda,
                                        const u16* __restrict__ Bt, int ldb, int K, u16* sA, u16* sB) {
  const int tid = otid(), lane = tid & 63, w = tid >> 6, wm = w >> 1, wn = w & 1, fr = lane & 15, fq = lane >> 4;
  u32x4 ra[4], rb[NW];
#pragma unroll
  for (int i = 0; i < 4; i++) {
    int c = tid + i * 256, row = c >> 3, kc = c & 7;
    ra[i] = *(const u32x4*)(A + (size_t)row * lda + kc * 8);
    if (i < NW) rb[i] = *(const u32x4*)(Bt + (size_t)row * ldb + kc * 8);
  }
  for (int k0 = 0; k0 < K; k0 += 64) {
#pragma unroll
    for (int i = 0; i < 4; i++) {
      int c = tid + i * 256, row = c >> 3, kc = c & 7;
      *(u32x4*)(sA + row * LDSK + kc * 8) = ra[i];
      if (i < NW) *(u32x4*)(sB + row * LDSK + kc * 8) = rb[i];
    }
    __syncthreads();
    if (k0 + 64 < K) {
#pragma unroll
      for (int i = 0; i < 4; i++) {
        int c = tid + i * 256, row = c >> 3, kc = c & 7;
        ra[i] = *(const u32x4*)(A + (size_t)row * lda + k0 + 64 + kc * 8);
        if (i < NW) rb[i] = *(const u32x4*)(Bt + (size_t)row * ldb + k0 + 64 + kc * 8);
      }
    }
#pragma unroll
    for (int ks = 0; ks < 2; ks++) {
      bf16x8 af[4], bfr[NW];
#pragma unroll
      for (int m = 0; m < 4; m++) af[m] = ldfrag(sA + (wm * 64 + m * 16 + fr) * LDSK + ks * 32 + fq * 8);
#pragma unroll
      for (int n = 0; n < NW; n++) bfr[n] = ldfrag(sB + (wn * 16 * NW + n * 16 + fr) * LDSK + ks * 32 + fq * 8);
#pragma unroll
      for (int m = 0; m < 4; m++)
#pragma unroll
        for (int n = 0; n < NW; n++) acc[m][n] = MFMA(af[m], bfr[n], acc[m][n]);
    }
    __syncthreads();
  }
}
#define ZERO_ACC(a, NWV)                                                                                  \
  _Pragma("unroll") for (int m_ = 0; m_ < 4; m_++) _Pragma("unroll") for (int n_ = 0; n_ < NWV; n_++) a[m_][n_] = \
      f32x4{0.f, 0.f, 0.f, 0.f};

__device__ __forceinline__ int swz1k(int ob) { return ob ^ (((ob >> 9) & 1) << 5); }
template <int MW, int NW, bool SWAP = false>
__device__ __forceinline__ void gemm_dma(f32x4 (&acc)[MW][NW], const u16* __restrict__ A, int lda,
                                         const u16* __restrict__ Bt, int ldb, int K, char* smem) {
  constexpr int BM = 32 * MW, BN = 32 * NW, STG = (BM + BN) * 64, NLA = BM / 64, NLB = BN / 64, NL = NLA + NLB;
  const int tid = otid(), lane = tid & 63, w = tid >> 6, wm = w >> 1, wn = w & 1, fr = lane & 15, fq = lane >> 4;
  int offA[NLA], offB[NLB];
#pragma unroll
  for (int i = 0; i < NLA; i++) {
    int b = (tid + i * 256) * 16, st = b >> 10, sw = swz1k(b & 1023);
    offA[i] = (st * 16 + (sw >> 6)) * lda + ((sw & 63) >> 1);
  }
#pragma unroll
  for (int i = 0; i < NLB; i++) {
    int b = (tid + i * 256) * 16, st = b >> 10, sw = swz1k(b & 1023);
    offB[i] = (st * 16 + (sw >> 6)) * ldb + ((sw & 63) >> 1);
  }
  const int fo = swz1k(fr * 64 + fq * 16);
  const int nk = K >> 5;
  auto issue = [&](int t) {
    char* stg = smem + (t % 3) * STG;
#pragma unroll
    for (int i = 0; i < NLA; i++)
      __builtin_amdgcn_global_load_lds((const unsigned*)(A + offA[i] + t * 32), (unsigned*)(stg + (tid + i * 256) * 16), 16, 0,
                                       0);
#pragma unroll
    for (int i = 0; i < NLB; i++)
      __builtin_amdgcn_global_load_lds((const unsigned*)(Bt + offB[i] + t * 32),
                                       (unsigned*)(stg + BM * 64 + (tid + i * 256) * 16), 16, 0, 0);
  };
  issue(0);
  if (nk > 1) issue(1);
  for (int t = 0; t < nk; t++) {
    if (t + 1 < nk) asm volatile("s_waitcnt vmcnt(%0)" ::"n"(NL) : "memory");
    else asm volatile("s_waitcnt vmcnt(0)" ::: "memory");
    __builtin_amdgcn_s_barrier();
    const char* stg = smem + (t % 3) * STG;
    bf16x8 af[MW], bfr[NW];
#pragma unroll
    for (int m = 0; m < MW; m++) af[m] = *(const bf16x8*)(stg + (wm * MW + m) * 1024 + fo);
#pragma unroll
    for (int n = 0; n < NW; n++) bfr[n] = *(const bf16x8*)(stg + BM * 64 + (wn * NW + n) * 1024 + fo);
    if (t + 2 < nk) issue(t + 2);
    __builtin_amdgcn_s_setprio(1);
#pragma unroll
    for (int m = 0; m < MW; m++)
#pragma unroll
      for (int n = 0; n < NW; n++) acc[m][n] = SWAP ? MFMA(bfr[n], af[m], acc[m][n]) : MFMA(af[m], bfr[n], acc[m][n]);
    __builtin_amdgcn_s_setprio(0);
  }
  __builtin_amdgcn_s_barrier();
}
#define ZERO_ACC2(a, MWV, NWV)                                                                              \
  _Pragma("unroll") for (int m_ = 0; m_ < MWV; m_++) _Pragma("unroll") for (int n_ = 0; n_ < NWV; n_++) a[m_][n_] = \
      f32x4{0.f, 0.f, 0.f, 0.f};
__device__ __forceinline__ void tile_of(int id, int ntiles, int NT, int& mt, int& nt) {
  int q = (id & 7) * (ntiles >> 3) + (id >> 3);
  mt = (q / (NT * 8)) * 8 + (q & 7);
  nt = (q >> 3) % NT;
}

__device__ __forceinline__ void phase_G1(const Params& p, int l, char* smem) {
  const int tid = otid(), lane = tid & 63, w = tid >> 6, wm = w >> 1, wn = w & 1, fr = lane & 15, fq = lane >> 4;
  constexpr int NT = NW1 / 128, MTL = TH / 256;
  const u16* W = p.WinT + (size_t)l * NWIN * D;
  for (int id = blockIdx.x; id < NT * MTL; id += gridDim.x) {
    int mt, nt;
    tile_of(id, NT * MTL, NT, mt, nt);
    int n0 = nt * 128;
    u16* dst;
    int ldd, cb, act = 0, mode = 0;
    if (n0 < 1536) { dst = p.Aqkv; ldd = 1536; cb = n0; }
    else if (n0 < 3072) { dst = p.Bqkv; ldd = 1024; cb = n0 - 1536; mode = (cb < 1024) ? 1 : 3; }
    else if (n0 < 4096) { dst = p.Cqkv; ldd = 768; cb = n0 - 3072; mode = (cb < 768) ? 2 : 4; }
    else if (n0 < 5120) { dst = p.Dqkv; ldd = 1024; cb = n0 - 4096; }
    else if (n0 < 7680) { dst = p.Z; ldd = 2560; cb = n0 - 5120; act = (cb < 2048) ? 1 : 2; }
    else { dst = nullptr; ldd = 0; cb = 0; }
    f32x4 acc[8][4];
    ZERO_ACC2(acc, 8, 4);
    if (mode == 0) gemm_dma<8, 4, true>(acc, p.hbuf + (size_t)mt * 256 * D, D, W + (size_t)nt * 128 * D, D, D, smem);
    else gemm_dma<8, 4, false>(acc, p.hbuf + (size_t)mt * 256 * D, D, W + (size_t)nt * 128 * D, D, D, smem);
    if (mode == 1) {
      const int te = otid(), fr = te & 15, fq = (te >> 4) & 3, wm = te >> 7, wn = (te >> 6) & 1;
      const float* g = (cb < 512 ? p.na_q_norm : p.na_k_norm) + l * 64;
      float gv[4];
      const float qs = (cb < 512) ? 0.125f * 1.4426950408889634f : 1.f;
#pragma unroll
      for (int n = 0; n < 4; n++) gv[n] = g[n * 16 + fr] * qs;
#pragma unroll
      for (int m = 0; m < 8; m++)
#pragma unroll
        for (int j = 0; j < 4; j++) {
          float ss = 0.f;
#pragma unroll
          for (int n = 0; n < 4; n++) ss += acc[m][n][j] * acc[m][n][j];
          ss = grp16_sum(ss);
          float sc = rsqrtf(ss * (1.f / 64.f) + EPS);
          int row = mt * 256 + wm * 128 + m * 16 + fq * 4 + j;
#pragma unroll
          for (int n = 0; n < 4; n++)
            dst[(size_t)row * ldd + cb + wn * 64 + n * 16 + fr] = f2bf(acc[m][n][j] * sc * gv[n]);
        }
    } else if (mode == 2) {
      float* sX = (float*)smem;
      const int te = otid(), fr = te & 15, fq = (te >> 4) & 3, wm = te >> 7, wn = (te >> 6) & 1;
      const float* g = (cb < 512 ? p.ga_q_norm : p.ga_k_norm) + l * 128 + wn * 64;
      float gv[4];
      const float qs = (cb < 512) ? 0.08838834764831845f * 1.4426950408889634f : 1.f;
#pragma unroll
      for (int n = 0; n < 4; n++) gv[n] = g[n * 16 + fr] * qs;
#pragma unroll
      for (int m = 0; m < 8; m++)
#pragma unroll
        for (int j = 0; j < 4; j++) {
          float ss = 0.f;
#pragma unroll
          for (int n = 0; n < 4; n++) ss += acc[m][n][j] * acc[m][n][j];
          ss = grp16_sum(ss);
          if (fr == 0) sX[(wm * 128 + m * 16 + fq * 4 + j) * 2 + wn] = ss;
        }
      __syncthreads();
      float inv[2];
#pragma unroll
      for (int n = 0; n < 2; n++) inv[n] = exp2f(-(float)(n * 16 + fr) * (13.287712379549449f / 32.f));
#pragma unroll
      for (int m = 0; m < 8; m++)
#pragma unroll
        for (int j = 0; j < 4; j++) {
          int rl = wm * 128 + m * 16 + fq * 4 + j, row = mt * 256 + rl;
          float sc = rsqrtf((sX[rl * 2] + sX[rl * 2 + 1]) * (1.f / 128.f) + EPS);
          int ts = row & (SEQ - 1);
          float pos = wn ? (float)(ts & 63) : (float)(ts >> 6);
#pragma unroll
          for (int n = 0; n < 2; n++) {
            float ang = pos * inv[n];
            float kf = rintf(ang * 0.15915494309189535f);
            float rr = fmaf(-kf, 6.2831855f, ang);
            rr = fmaf(-kf, -1.7484555e-7f, rr);
            float sn = __sinf(rr), cs = __cosf(rr);
            float y1 = acc[m][n][j] * sc * gv[n], y2 = acc[m][n + 2][j] * sc * gv[n + 2];
            u16* o = dst + (size_t)row * ldd + cb + wn * 64 + n * 16 + fr;
            o[0] = f2bf(y1 * cs - y2 * sn);
            o[32] = f2bf(y1 * sn + y2 * cs);
          }
          __builtin_amdgcn_sched_barrier(0);
        }
      __syncthreads();
    } else if (mode >= 3) {
      const int te = otid(), fr = te & 15, fq = (te >> 4) & 3, wm = te >> 7, wn = (te >> 6) & 1;
      const int row0 = mt * 256 + wm * 128, bl = row0 >> 11;
      u16* vt;
      if (mode == 3) vt = p.VtB + ((size_t)(bl * 8 + ((cb - 1024) >> 6) + wn) * 64) * SEQ;
      else vt = p.VtC + ((size_t)(bl * 2 + ((cb - 768) >> 7)) * 128 + wn * 64) * SEQ;
#pragma unroll
      for (int m = 0; m < 8; m++)
#pragma unroll
        for (int n = 0; n < 4; n++) {
          u32x2 o;
          o.x = pack2(acc[m][n][0], acc[m][n][1]);
          o.y = pack2(acc[m][n][2], acc[m][n][3]);
          *(u32x2*)(vt + (size_t)(n * 16 + fr) * SEQ + ((row0 + m * 16 + fq * 4) & (SEQ - 1))) = o;
        }
    } else {
      const int te = otid(), fr = te & 15, fq = (te >> 4) & 3, wm = te >> 7, wn = (te >> 6) & 1;
#pragma unroll
      for (int m = 0; m < 8; m++)
#pragma unroll
        for (int n = 0; n < 4; n++) {
          const int row = mt * 256 + wm * 128 + m * 16 + fr, col0 = wn * 64 + n * 16 + fq * 4;
          f32x4 v = acc[m][n];
          if (dst) {
            if (act == 1) { v[0] = siluf_(v[0]); v[1] = siluf_(v[1]); v[2] = siluf_(v[2]); v[3] = siluf_(v[3]); }
            else if (act == 2) { v[0] = sigmoidf_(v[0]); v[1] = sigmoidf_(v[1]); v[2] = sigmoidf_(v[2]); v[3] = sigmoidf_(v[3]); }
            u32x2 o;
            o.x = pack2(v[0], v[1]);
            o.y = pack2(v[2], v[3]);
            *(u32x2*)(dst + (size_t)row * ldd + cb + col0) = o;
          } else if (col0 < 32) {
            *(f32x4*)(p.Sm + (size_t)row * 32 + col0) = v;
          }
        }
    }
  }
}

__device__ __forceinline__ void dn_prep_item(const Params& p, int l, int item, char* smem) {
  const int tid = otid(), lane = tid & 63, w = tid >> 6, fr = lane & 15, fq = lane >> 4;
  const int c = item & 31, h = (item >> 5) & 3, bl = item >> 7;
  u16* sQ = (u16*)smem;
  u16* sK = sQ + 64 * 136;
  float* sAm = (float*)(sK + 64 * 136);
  float* sBeta = sAm + 2 * 64 * 68;
  float* sGc = sBeta + 128;
  const size_t tbase = (size_t)bl * SEQ;
  const int t0 = c * 64;
  for (int part = 0; part < 3; part++) {
    const int ch = part * 512 + h * 128 + 2 * lane;
    float w0[5], w1[5];
#pragma unroll
    for (int j = 0; j < 5; j++) {
      w0[j] = p.conv_a[((size_t)l * 5 + j) * 1536 + ch];
      w1[j] = p.conv_a[((size_t)l * 5 + j) * 1536 + ch + 1];
    }
    const int rs = t0 + w * 16;
    unsigned xin[20];
#pragma unroll
    for (int r = 0; r < 20; r++) {
      int t = rs - 2 + r;
      xin[r] = (t >= 0 && t < SEQ) ? *(const unsigned*)(p.Aqkv + (tbase + t) * 1536 + ch) : 0u;
    }
    float y0[16], y1[16];
#pragma unroll
    for (int rr = 0; rr < 16; rr++) {
      float a0 = 0.f, a1 = 0.f;
#pragma unroll
      for (int j = 0; j < 5; j++) {
        a0 += w0[j] * bf2f((u16)(xin[rr + j] & 0xffff));
        a1 += w1[j] * bf2f((u16)(xin[rr + j] >> 16));
      }
      y0[rr] = siluf_(a0);
      y1[rr] = siluf_(a1);
    }
    if (part < 2) {
      float ss[16];
#pragma unroll
      for (int rr = 0; rr < 16; rr++) ss[rr] = y0[rr] * y0[rr] + y1[rr] * y1[rr];
#pragma unroll
      for (int o = 32; o >= 1; o >>= 1)
#pragma unroll
        for (int rr = 0; rr < 16; rr++) ss[rr] += __shfl_xor(ss[rr], o);
#pragma unroll
      for (int rr = 0; rr < 16; rr++) {
        float sc = rsqrtf(ss[rr] + EPS) * (part == 0 ? 0.08838834764831845f : 1.f);
        unsigned pk = pack2(y0[rr] * sc, y1[rr] * sc);
        *(unsigned*)((part == 0 ? sQ : sK) + (w * 16 + rr) * 136 + 2 * lane) = pk;
        *(unsigned*)(p.qkvc + ((size_t)(bl * 4 + h) * SEQ + rs + rr) * 384 + part * 128 + 2 * lane) = pk;
      }
    } else {
#pragma unroll
      for (int rr = 0; rr < 16; rr++) *(unsigned*)(p.qkvc + ((size_t)(bl * 4 + h) * SEQ + rs + rr) * 384 + part * 128 + 2 * lane) = pack2(y0[rr], y1[rr]);
    }
  }
  if (w < 2) {
    const int d = w, ip = lane;
    const int t = t0 + (d ? 63 - ip : ip);
    float apre = p.Sm[(tbase + t) * 32 + d * 4 + h];
    float bpre = p.Sm[(tbase + t) * 32 + 8 + d * 4 + h];
    float g = -__expf(p.dn_a_log[l * 8 + d * 4 + h]) * softplusf_(apre + p.dn_dt_bias[l * 8 + d * 4 + h]);
    float beta = 1.f / (1.f + __expf(-bpre));
    float gc = g;
#pragma unroll
    for (int off = 1; off < 64; off <<= 1) {
      float v = __shfl_up(gc, off);
      if (lane >= off) gc += v;
    }
    sBeta[d * 64 + ip] = beta;
    sGc[d * 64 + ip] = gc;
  }
  __syncthreads();
  {
    f32x4 akk[4], aqk[4];
#pragma unroll
    for (int n = 0; n < 4; n++) { akk[n] = f32x4{0, 0, 0, 0}; aqk[n] = f32x4{0, 0, 0, 0}; }
#pragma unroll
    for (int ks = 0; ks < 4; ks++) {
      bf16x8 fk = ldfrag(sK + (16 * w + fr) * 136 + ks * 32 + fq * 8);
      bf16x8 fqv = ldfrag(sQ + (16 * w + fr) * 136 + ks * 32 + fq * 8);
#pragma unroll
      for (int n = 0; n < 4; n++) {
        bf16x8 fb = ldfrag(sK + (n * 16 + fr) * 136 + ks * 32 + fq * 8);
        akk[n] = MFMA(fk, fb, akk[n]);
        aqk[n] = MFMA(fqv, fb, aqk[n]);
      }
    }
#pragma unroll
    for (int d = 0; d < 2; d++) {
      u16* Pg = p.TP + ((size_t)(item * 2 + d) * 2 + 1) * 4096;
#pragma unroll
      for (int n = 0; n < 4; n++)
#pragma unroll
        for (int j = 0; j < 4; j++) {
          int i = 16 * w + fq * 4 + j, jj = n * 16 + fr;
          int ip = d ? 63 - i : i, jp = d ? 63 - jj : jj;
          float e = (jp <= ip) ? __expf(sGc[d * 64 + ip] - sGc[d * 64 + jp]) : 0.f;
          float av = (jp < ip) ? sBeta[d * 64 + ip] * akk[n][j] * e : 0.f;
          sAm[(d * 64 + ip) * 68 + jp] = av;
          Pg[ip * 64 + jp] = f2bf(aqk[n][j] * e);
        }
    }
  }
  __syncthreads();
  {
#pragma unroll
    for (int d = 0; d < 2; d++) {
      int jp = lane, j = d ? 63 - jp : jp;
      float e = __expf(sGc[d * 64 + 63] - sGc[d * 64 + jp]);
      u16* Kg = p.KdT + (size_t)(item * 2 + d) * 8192;
#pragma unroll
      for (int c8 = 0; c8 < 4; c8++) {
        const int dk0 = w * 32 + c8 * 8;
        u32x4 kv = *(const u32x4*)(sK + j * 136 + dk0);
#pragma unroll
        for (int e2 = 0; e2 < 4; e2++) {
          Kg[(dk0 + 2 * e2) * 64 + jp] = f2bf(bf2f((u16)(kv[e2] & 0xffff)) * e);
          Kg[(dk0 + 2 * e2 + 1) * 64 + jp] = f2bf(bf2f((u16)(kv[e2] >> 16)) * e);
        }
      }
    }
    if (w >= 2) {
      int d = w - 2;
      float* vb = p.vecs + (size_t)(item * 2 + d) * 144;
      vb[lane] = sBeta[d * 64 + lane];
      vb[64 + lane] = __expf(sGc[d * 64 + lane]);
      if (lane == 0) vb[128] = __expf(sGc[d * 64 + 63]);
    }
  }
  if (w < 2) {
    const int d = w;
    const float* Am = sAm + d * 64 * 68;
    int cc = lane;
    asm volatile("" : "+v"(cc));
    float x[64];
#pragma unroll
    for (int i = 0; i < 64; i++) {
      float s = (i == cc) ? 1.f : 0.f;
#pragma unroll
      for (int j = 0; j < i; j++) s -= Am[i * 68 + j] * x[j];
      x[i] = s;
      __builtin_amdgcn_sched_barrier(0);
    }
    u16* Tg = p.TP + ((size_t)(item * 2 + d) * 2 + 0) * 4096;
#pragma unroll
    for (int i = 0; i < 64; i++) Tg[i * 64 + cc] = f2bf(x[i]);
  }
  __syncthreads();
}

__device__ __forceinline__ void phase_P2(const Params& p, int l, char* smem) {
  for (int item = blockIdx.x; item < NCHK; item += gridDim.x) dn_prep_item(p, l, item, smem);
}

__device__ __forceinline__ void lds_barrier() { asm volatile("s_waitcnt lgkmcnt(0)\n\ts_barrier" ::: "memory"); }
struct DnStep {
  bf16x8 ka[4], ta[2];
  float v[2][4], beta[4], egc[4], gtot;
};
struct DnLate {
  bf16x8 qa[4], pa[2], kd[2][2];
};
__device__ __forceinline__ void dn_load(DnStep& s, const Params& p, int bl, int h, int d, int sl, int cn, int w,
                                        int fr, int fq) {
  const int c = d ? 31 - cn : cn;
  const int pd = (((bl * 4 + h) * 32 + c) * 2 + d);
  const u16* Tg = p.TP + (size_t)pd * 8192;
  const float* vb = p.vecs + (size_t)pd * 144;
  const size_t tb = (size_t)(bl * 4 + h) * SEQ + c * 64;
  const int ipA = 16 * w + fr;
  const u16* krow = p.qkvc + (tb + (d ? 63 - ipA : ipA)) * 384 + 128;
#pragma unroll
  for (int ks = 0; ks < 4; ks++) s.ka[ks] = ldfrag(krow + ks * 32 + fq * 8);
#pragma unroll
  for (int ks = 0; ks < 2; ks++) s.ta[ks] = ldfrag(Tg + (16 * w + fr) * 64 + ks * 32 + fq * 8);
#pragma unroll
  for (int j = 0; j < 4; j++) {
    int ip = 16 * w + fq * 4 + j;
    s.beta[j] = vb[ip];
    s.egc[j] = vb[64 + ip];
    size_t t = tb + (d ? 63 - ip : ip);
#pragma unroll
    for (int n = 0; n < 2; n++) s.v[n][j] = bf2f(p.qkvc[t * 384 + 256 + sl * 32 + n * 16 + fr]);
  }
  s.gtot = vb[128];
}
__device__ __forceinline__ void dn_load_q(DnLate& s, const Params& p, int bl, int h, int d, int cn, int w, int fr,
                                          int fq) {
  const int c = d ? 31 - cn : cn;
  const size_t tb = (size_t)(bl * 4 + h) * SEQ + c * 64;
  const int ipA = 16 * w + fr;
  const u16* qrow = p.qkvc + (tb + (d ? 63 - ipA : ipA)) * 384;
#pragma unroll
  for (int ks = 0; ks < 4; ks++) s.qa[ks] = ldfrag(qrow + ks * 32 + fq * 8);
}
__device__ __forceinline__ void dn_load_pk(DnLate& s, const Params& p, int bl, int h, int d, int cn, int w, int fr,
                                           int fq) {
  const int c = d ? 31 - cn : cn;
  const int pd = (((bl * 4 + h) * 32 + c) * 2 + d);
  const u16* Pg = p.TP + (size_t)pd * 8192 + 4096;
  const u16* Kg = p.KdT + (size_t)pd * 8192;
#pragma unroll
  for (int ks = 0; ks < 2; ks++) {
    s.pa[ks] = ldfrag(Pg + (16 * w + fr) * 64 + ks * 32 + fq * 8);
#pragma unroll
    for (int m = 0; m < 2; m++) s.kd[m][ks] = ldfrag(Kg + (32 * w + m * 16 + fr) * 64 + ks * 32 + fq * 8);
  }
}
__device__ __forceinline__ void dn_step(const Params& p, int bl, const DnStep& cur, DnLate& lt, f32x4 (&Sacc)[2][2],
                                        u16* sST, u16* sRT, u16* sVnT, u16* og, size_t tbase, int cn, int d, int h,
                                        int sl, int w, int fr, int fq) {
  const int c = d ? 31 - cn : cn;
  const int cb = c * 64;
  const int cnn = cn + 1 < 32 ? cn + 1 : 31;
#pragma unroll
  for (int m = 0; m < 2; m++)
#pragma unroll
    for (int n = 0; n < 2; n++) {
      u32x2 o;
      o.x = pack2(Sacc[m][n][0], Sacc[m][n][1]);
      o.y = pack2(Sacc[m][n][2], Sacc[m][n][3]);
      *(u32x2*)(sST + (n * 16 + fr) * 136 + 32 * w + m * 16 + fq * 4) = o;
    }
  lds_barrier();
  f32x4 kS[2];
  kS[0] = kS[1] = f32x4{0, 0, 0, 0};
#pragma unroll
  for (int ks = 0; ks < 4; ks++) {
#pragma unroll
    for (int n = 0; n < 2; n++) kS[n] = MFMA(cur.ka[ks], ldfrag(sST + (n * 16 + fr) * 136 + ks * 32 + fq * 8), kS[n]);
  }
#pragma unroll
  for (int n = 0; n < 2; n++) {
    float r[4];
#pragma unroll
    for (int j = 0; j < 4; j++) r[j] = cur.beta[j] * (cur.v[n][j] - cur.egc[j] * kS[n][j]);
    u32x2 o;
    o.x = pack2(r[0], r[1]);
    o.y = pack2(r[2], r[3]);
    *(u32x2*)(sRT + (n * 16 + fr) * 72 + 16 * w + fq * 4) = o;
  }
  lds_barrier();
  f32x4 vn[2];
  vn[0] = vn[1] = f32x4{0, 0, 0, 0};
#pragma unroll
  for (int ks = 0; ks < 2; ks++)
#pragma unroll
    for (int n = 0; n < 2; n++) vn[n] = MFMA(cur.ta[ks], ldfrag(sRT + (n * 16 + fr) * 72 + ks * 32 + fq * 8), vn[n]);
  f32x4 qS[2];
  qS[0] = qS[1] = f32x4{0, 0, 0, 0};
#pragma unroll
  for (int ks = 0; ks < 4; ks++) {
#pragma unroll
    for (int n = 0; n < 2; n++) qS[n] = MFMA(lt.qa[ks], ldfrag(sST + (n * 16 + fr) * 136 + ks * 32 + fq * 8), qS[n]);
  }
  dn_load_q(lt, p, bl, h, d, cnn, w, fr, fq);
#pragma unroll
  for (int n = 0; n < 2; n++) {
    u32x2 o;
    o.x = pack2(vn[n][0], vn[n][1]);
    o.y = pack2(vn[n][2], vn[n][3]);
    *(u32x2*)(sVnT + (n * 16 + fr) * 72 + 16 * w + fq * 4) = o;
  }
  lds_barrier();
  f32x4 oo[2];
  oo[0] = oo[1] = f32x4{0, 0, 0, 0};
#pragma unroll
  for (int m = 0; m < 2; m++)
#pragma unroll
    for (int n = 0; n < 2; n++) Sacc[m][n] *= cur.gtot;
#pragma unroll
  for (int ks = 0; ks < 2; ks++) {
    bf16x8 vbf[2];
#pragma unroll
    for (int n = 0; n < 2; n++) vbf[n] = ldfrag(sVnT + (n * 16 + fr) * 72 + ks * 32 + fq * 8);
#pragma unroll
    for (int n = 0; n < 2; n++) oo[n] = MFMA(lt.pa[ks], vbf[n], oo[n]);
#pragma unroll
    for (int m = 0; m < 2; m++)
#pragma unroll
      for (int n = 0; n < 2; n++) Sacc[m][n] = MFMA(lt.kd[m][ks], vbf[n], Sacc[m][n]);
  }
#pragma unroll
  for (int n = 0; n < 2; n++)
#pragma unroll
    for (int j = 0; j < 4; j++) {
      int ip = 16 * w + fq * 4 + j;
      size_t t = tbase + cb + (d ? 63 - ip : ip);
      og[t * 512 + h * 128 + sl * 32 + n * 16 + fr] = f2bf(cur.egc[j] * qS[n][j] + oo[n][j]);
    }
  dn_load_pk(lt, p, bl, h, d, cnn, w, fr, fq);
}
__device__ __forceinline__ void dn_scan_item(const Params& p, int item, char* smem) {
  const int tid = otid(), lane = tid & 63, w = tid >> 6, fr = lane & 15, fq = lane >> 4;
  const int sl = item & 3, d = (item >> 2) & 1, h = (item >> 3) & 3, bl = item >> 5;
  u16* sST = (u16*)smem;
  u16* sRT = sST + 32 * 136;
  u16* sVnT = sRT + 32 * 72;
  const size_t tbase = (size_t)bl * SEQ;
  u16* og = p.Aqkv + (size_t)d * TH * 512;
  f32x4 Sacc[2][2];
#pragma unroll
  for (int m = 0; m < 2; m++)
#pragma unroll
    for (int n = 0; n < 2; n++) Sacc[m][n] = f32x4{0, 0, 0, 0};
  DnStep sa, sb;
  DnLate lt;
  dn_load(sa, p, bl, h, d, sl, 0, w, fr, fq);
  dn_load_q(lt, p, bl, h, d, 0, w, fr, fq);
  dn_load_pk(lt, p, bl, h, d, 0, w, fr, fq);
  __syncthreads();
  for (int cn = 0; cn < 32; cn += 2) {
    dn_load(sb, p, bl, h, d, sl, cn + 1, w, fr, fq);
    dn_step(p, bl, sa, lt, Sacc, sST, sRT, sVnT, og, tbase, cn, d, h, sl, w, fr, fq);
    if (cn + 2 < 32) dn_load(sa, p, bl, h, d, sl, cn + 2, w, fr, fq);
    dn_step(p, bl, sb, lt, Sacc, sST, sRT, sVnT, og, tbase, cn + 1, d, h, sl, w, fr, fq);
  }
  __syncthreads();
}

struct MlStep { u32x4 q[2], k[2], v; };
__device__ __forceinline__ void ml_load(MlStep& s, const Params& p, size_t tbase, int h, int d, int sl, int cn,
                                        int tid) {
  const int c = d ? 31 - cn : cn, cb = c * 64;
#pragma unroll
  for (int i = 0; i < 2; i++) {
    int cidx = tid + i * 256, ip = cidx >> 3, kc = cidx & 7;
    const size_t t = tbase + cb + (d ? 63 - ip : ip);
    s.q[i] = *(const u32x4*)(p.Dqkv + t * 1024 + h * 64 + kc * 8);
    s.k[i] = *(const u32x4*)(p.Dqkv + t * 1024 + 256 + h * 64 + kc * 8);
  }
  {
    int ip = tid >> 2, kc = tid & 3;
    const size_t t = tbase + cb + (d ? 63 - ip : ip);
    s.v = *(const u32x4*)(p.Dqkv + t * 1024 + 512 + h * 128 + sl * 32 + kc * 8);
  }
}
struct MlG { float ipre, fpre; };
__device__ __forceinline__ void ml_gload(MlG& g, const Params& p, size_t tbase, int h, int d, int cn, int lane) {
  const int c = d ? 31 - cn : cn, cb = c * 64, ip = lane;
  const size_t t = tbase + cb + (d ? 63 - ip : ip);
  g.ipre = p.Sm[t * 32 + 16 + d * 4 + h];
  g.fpre = p.Sm[t * 32 + 24 + d * 4 + h];
}
__device__ __forceinline__ void ml_gates(const MlG& g, int lane, float ib, float fb, float* sG) {
  const int ip = lane;
  float ig = g.ipre + ib;
  float lf = logsigmoidf_(g.fpre + fb);
  float b = lf;
#pragma unroll
  for (int off = 1; off < 64; off <<= 1) {
    float v = __shfl_up(b, off);
    if (lane >= off) b += v;
  }
  float a = ig - b;
  float pm = a;
#pragma unroll
  for (int off = 1; off < 64; off <<= 1) {
    float v = __shfl_up(pm, off);
    if (lane >= off) pm = fmaxf(pm, v);
  }
  const float pml = __shfl(pm, 63);
  sG[ip] = a;
  sG[64 + ip] = pm;
  sG[128 + ip] = b;
  sG[192 + ip] = __expf(a - pml);
  sG[256 + ip] = 0.125f * __expf(fminf(pml - pm, 80.f));
}
struct MlCtx {
  u16 *sQ, *sK, *sKT, *sS, *sVT, *sCT;
  float* sGall;
  u16* og;
  size_t tbase;
  float ib, fb;
  int h, d, sl, tid, lane, w, fr, fq, vf;
};
__device__ __forceinline__ void ml_step(const Params& p, const MlStep& cur, const MlG& gnext, f32x4 (&Cacc)[3],
                                        float& m_st, const MlCtx& x, int cn) {
  u16 *sQ = x.sQ, *sK = x.sK, *sKT = x.sKT, *sS = x.sS, *sVT = x.sVT, *sCT = x.sCT;
  float* sGall = x.sGall;
  u16* og = x.og;
  const size_t tbase = x.tbase;
  const float ib = x.ib, fb = x.fb;
  const int h = x.h, d = x.d, sl = x.sl, tid = x.tid, lane = x.lane, w = x.w, fr = x.fr, fq = x.fq;
    const int c = d ? 31 - cn : cn;
  const int cb = c * 64;
  const float* sA = sGall + (cn & 1) * 320;
  const float* sEa = sA + 192;
  const float* sEp = sA + 256;
  const float* sPm = sA + 64;
  const float* sBv = sA + 128;
  const float pm_last = sPm[63], b_last = sBv[63];
#pragma unroll
  for (int i = 0; i < 2; i++) {
    int cidx = tid + i * 256, ip = cidx >> 3, kc = cidx & 7;
    *(u32x4*)(sQ + ip * 72 + kc * 8) = cur.q[i];
    *(u32x4*)(sK + ip * 72 + kc * 8) = cur.k[i];
    u32x4 uk = cur.k[i];
    float wsc = sEa[ip] * 0.125f;
    u16* dst = sKT + (kc * 8) * 72 + ((((ip >> 3) ^ kc) & 7) * 8) + (ip & 7);
#pragma unroll
    for (int e = 0; e < 4; e++) {
      unsigned pk = pack2(bf2f((u16)(uk[e] & 0xffff)) * wsc, __uint_as_float(uk[e] & 0xffff0000u) * wsc);
      dst[(2 * e) * 72] = (u16)(pk & 0xffff);
      dst[(2 * e + 1) * 72] = (u16)(pk >> 16);
    }
  }
  {
    int ip = tid >> 2, kc = tid & 3;
    u32x4 uv = cur.v;
    u16* dst = sVT + (kc * 8) * 72 + ((((ip >> 3) ^ kc) & 7) * 8) + (ip & 7);
#pragma unroll
    for (int e = 0; e < 4; e++) {
      dst[(2 * e) * 72] = (u16)(uv[e] & 0xffff);
      dst[(2 * e + 1) * 72] = (u16)(uv[e] >> 16);
    }
  }
#pragma unroll
  for (int n = 0; n < 3; n++) {
    u32x2 o;
    o.x = pack2(Cacc[n][0], Cacc[n][1]);
    o.y = pack2(Cacc[n][2], Cacc[n][3]);
    *(u32x2*)(sCT + (n * 16 + fr) * 72 + 16 * w + fq * 4) = o;
  }
  lds_barrier();
  if (w == 3 && cn + 1 < 32) ml_gates(gnext, lane, ib, fb, sGall + ((cn + 1) & 1) * 320);
  {
    f32x4 s1[4];
#pragma unroll
    for (int n = 0; n < 4; n++) s1[n] = f32x4{0, 0, 0, 0};
#pragma unroll
    for (int ks = 0; ks < 2; ks++) {
      bf16x8 qa = ldfrag(sQ + (16 * w + fr) * 72 + ks * 32 + fq * 8);
#pragma unroll
      for (int n = 0; n < 4; n++) s1[n] = MFMA(qa, ldfrag(sK + (n * 16 + fr) * 72 + ks * 32 + fq * 8), s1[n]);
    }
    float eaj[4], epi[4];
#pragma unroll
    for (int n = 0; n < 4; n++) eaj[n] = sEa[n * 16 + fr];
#pragma unroll
    for (int j = 0; j < 4; j++) epi[j] = sEp[16 * w + fq * 4 + j];
#pragma unroll
    for (int n = 0; n < 4; n++)
#pragma unroll
      for (int j = 0; j < 4; j++) {
        int i = 16 * w + fq * 4 + j, jj = n * 16 + fr;
        float v = s1[n][j] * eaj[n] * epi[j];
        sS[i * 72 + jj] = f2bf(jj <= i ? v : 0.f);
      }
  }
  lds_barrier();
  f32x4 qC[3], SV[3], dC[3];
#pragma unroll
  for (int n = 0; n < 3; n++) qC[n] = SV[n] = dC[n] = f32x4{0, 0, 0, 0};
#pragma unroll
  for (int ks = 0; ks < 2; ks++) {
    bf16x8 qa = ldfrag(sQ + (16 * w + fr) * 72 + ks * 32 + fq * 8);
    bf16x8 sa = ldfrag(sS + (16 * w + fr) * 72 + ks * 32 + fq * 8);
    bf16x8 ka = ldfrag(sKT + (16 * w + fr) * 72 + ((((ks * 4 + fq) ^ (2 * w + (fr >> 3))) & 7) * 8));
#pragma unroll
    for (int n = 0; n < 3; n++) {
      bf16x8 cbf = ldfrag(sCT + (n * 16 + fr) * 72 + ks * 32 + fq * 8);
      bf16x8 vbf = ldfrag(sVT + (n * 16 + fr) * 72 + ((((ks * 4 + fq) ^ (2 * n + (fr >> 3))) & 7) * 8));
      qC[n] = MFMA(qa, cbf, qC[n]);
      SV[n] = MFMA(sa, vbf, SV[n]);
      dC[n] = MFMA(ka, vbf, dC[n]);
    }
  }
#pragma unroll
  for (int j = 0; j < 4; j++) {
    int i = 16 * w + fq * 4 + j;
    float pm_i = sPm[i], b_i = sBv[i];
    float rho = __expf(fminf(0.f, pm_i - m_st)), inter = __expf(fminf(0.f, m_st - pm_i));
    float qn = qC[2][j], rs = SV[2][j];
    float denom = inter * qn + rho * rs;
    float m_i = b_i + fmaxf(pm_i, m_st);
    float dn = 1.f / fmaxf(fabsf(denom), __expf(-m_i));
    size_t t = tbase + cb + (d ? 63 - i : i);
#pragma unroll
    for (int n = 0; n < 2; n++)
      if (!(x.vf & 1)) og[t * 512 + h * 128 + sl * 32 + n * 16 + fr] = f2bf((inter * qC[n][j] + rho * SV[n][j]) * dn);
      else asm volatile("" ::"v"((inter * qC[n][j] + rho * SV[n][j]) * dn));
  }
  {
    float sig = __expf(fminf(0.f, pm_last - m_st)), dec = __expf(fminf(0.f, m_st - pm_last));
#pragma unroll
    for (int n = 0; n < 3; n++) Cacc[n] = Cacc[n] * dec + dC[n] * sig;
    m_st = b_last + fmaxf(m_st, pm_last);
  }
  lds_barrier();
}
__device__ __forceinline__ void ml_scan_item(const Params& p, int l, int item, char* smem, int vf = 0) {
  MlCtx x;
  x.vf = vf;
  x.tid = otid(); x.lane = x.tid & 63; x.w = x.tid >> 6; x.fr = x.lane & 15; x.fq = x.lane >> 4;
  x.sl = item & 3; x.d = (item >> 2) & 1; x.h = (item >> 3) & 3;
  const int bl = item >> 5;
  x.sQ = (u16*)smem;
  x.sK = x.sQ + 64 * 72;
  x.sKT = x.sK + 64 * 72;
  x.sS = x.sKT + 64 * 72;
  x.sVT = x.sS + 64 * 72;
  x.sCT = x.sVT + 48 * 72;
  x.sGall = (float*)(x.sCT + 48 * 72);
  x.tbase = (size_t)bl * SEQ;
  x.og = x.d ? p.MLhb : (p.Aqkv + (size_t)2 * TH * 512);
  x.ib = p.ml_i_bias[l * 8 + x.d * 4 + x.h];
  x.fb = p.ml_f_bias[l * 8 + x.d * 4 + x.h];
  for (int e = x.tid; e < 16 * 72; e += 256) x.sVT[32 * 72 + e] = (u16)0x3f80;
  f32x4 Cacc[3];
  Cacc[0] = Cacc[1] = Cacc[2] = f32x4{0, 0, 0, 0};
  float m_st = 0.f;
  MlStep sa, sb;
  MlG g0, g1, g2;
  ml_load(sa, p, x.tbase, x.h, x.d, x.sl, 0, x.tid);
  ml_gload(g0, p, x.tbase, x.h, x.d, 0, x.lane);
  ml_gload(g1, p, x.tbase, x.h, x.d, 1, x.lane);
  if (x.w == 0) ml_gates(g0, x.lane, x.ib, x.fb, x.sGall);
  __syncthreads();
  for (int cn = 0; cn < 32; cn += 2) {
    if (!(vf & 2) || cn == 0) { ml_load(sb, p, x.tbase, x.h, x.d, x.sl, cn + 1, x.tid);
    ml_gload(g2, p, x.tbase, x.h, x.d, min(cn + 2, 31), x.lane); }
    ml_step(p, sa, g1, Cacc, m_st, x, cn);
    if (!(vf & 2)) { if (cn + 2 < 32) ml_load(sa, p, x.tbase, x.h, x.d, x.sl, cn + 2, x.tid);
    ml_gload(g1, p, x.tbase, x.h, x.d, min(cn + 3, 31), x.lane); }
    ml_step(p, sb, g2, Cacc, m_st, x, cn + 1);
  }
  __syncthreads();
}

template <int DH, int MT, bool NA>
__device__ __forceinline__ void attn_item(const u16* __restrict__ qbase, int ldq, const u16* __restrict__ kbase, int ldkv,
                                          const u16* __restrict__ vtbase, u16* __restrict__ obase, int ldo, int nkt,
                                          float scale, int r, int r0, const float* __restrict__ rpbh, char* smem) {
  const int tid = otid(), lane = tid & 63, w = tid >> 6, fr = lane & 15, fq = lane >> 4;
  constexpr int KS = DH / 32, ND = DH / 16, CPT = DH / 32, SPR = DH / 8;
  constexpr int NKT = NA ? 2 : 4, NTS = NA ? 1 : 2;
  const int kw = NA ? min(max(16 * w - 8, 0), 32) : 0;
  constexpr int KB = 64 * DH * 2, VB = DH * 128;
  char* sKb = smem;
  char* sVb = smem + 2 * KB;
  float* sBias = (float*)(smem + 2 * (KB + VB));
  if (NA)
    for (int e = tid; e < 15 * 31; e += 256) sBias[e] = rpbh[e];
  bf16x8 qf[MT][KS];
#pragma unroll
  for (int m = 0; m < MT; m++)
#pragma unroll
    for (int ks = 0; ks < KS; ks++)
      qf[m][ks] = ldfrag(qbase + (size_t)(w * 16 * MT + m * 16 + fr) * ldq + ks * 32 + fq * 8);
  f32x4 O[MT][ND];
  float mrow[MT], lrow[MT];
#pragma unroll
  for (int m = 0; m < MT; m++) {
#pragma unroll
    for (int n = 0; n < ND; n++) O[m][n] = f32x4{0, 0, 0, 0};
    mrow[m] = -1e30f;
    lrow[m] = 0.f;
  }
  const int koff = (tid / SPR) * ldkv + (((tid % SPR) ^ ((tid / SPR) & (SPR - 1))) * 8);
  const int voff = (tid >> 3) * SEQ + (((tid & 7) ^ ((tid >> 3) & 7)) * 8);
  auto gload = [&](int kt) {
    const u16* kg = kbase + (size_t)kt * 64 * ldkv;
    const u16* vg = vtbase + kt * 64;
    char* kdst = sKb + (kt & 1) * KB;
    char* vdst = sVb + (kt & 1) * VB;
#pragma unroll
    for (int i = 0; i < CPT; i++) {
      __builtin_amdgcn_global_load_lds((const unsigned*)(kg + koff + i * (256 / SPR) * ldkv),
                                       (unsigned*)(kdst + (tid + i * 256) * 16), 16, 0, 0);
      __builtin_amdgcn_global_load_lds((const unsigned*)(vg + voff + i * 32 * SEQ),
                                       (unsigned*)(vdst + (tid + i * 256) * 16), 16, 0, 0);
    }
  };
  gload(0);
  for (int kt = 0; kt < nkt; kt++) {
    const char* sKc = sKb + (kt & 1) * KB;
    const char* sVc = sVb + (kt & 1) * VB;
    asm volatile("s_waitcnt vmcnt(0)" ::: "memory");
    __builtin_amdgcn_s_barrier();
    if (kt + 1 < nkt) gload(kt + 1);
    f32x4 sT[MT][NKT];
#pragma unroll
    for (int m = 0; m < MT; m++)
#pragma unroll
      for (int n = 0; n < NKT; n++) sT[m][n] = f32x4{0, 0, 0, 0};
#pragma unroll
    for (int ks = 0; ks < KS; ks++) {
#pragma unroll
      for (int n = 0; n < NKT; n++) {
        const int krow = kw + n * 16 + fr;
        bf16x8 kb = *(const bf16x8*)(sKc + krow * (DH * 2) + (((ks * 4 + fq) ^ (krow & (SPR - 1))) * 16));
#pragma unroll
        for (int m = 0; m < MT; m++) sT[m][n] = MFMA(kb, qf[m][ks], sT[m][n]);
      }
    }
    bf16x8 pb[MT][NTS];
#pragma unroll
    for (int m = 0; m < MT; m++) {
      float mx = -1e30f;
#pragma unroll
      for (int n = 0; n < NKT; n++)
#pragma unroll
        for (int j = 0; j < 4; j++) {
          float v = sT[m][n][j];
          if (NA) {
            int cq = w * 16 * MT + m * 16 + fr, kc = kw + n * 16 + fq * 4 + j;
            int c0 = min(max(cq - 8, 0), 48);
            bool ok = (kc >= c0) && (kc < c0 + 16);
            v = ok ? fmaf(sBias[(r0 + kt - r + 7) * 31 + (kc - cq + 15)], 1.4426950408889634f, v) : -1e30f;
          }
          sT[m][n][j] = v;
          mx = fmaxf(mx, v);
        }
      mx = fmaxf(mx, __shfl_xor(mx, 16));
      mx = fmaxf(mx, __shfl_xor(mx, 32));
      const bool moved = mx > mrow[m] + 8.f;
      const float mnew = moved ? mx : mrow[m];
      if (__any(moved)) {
        float alpha = __builtin_amdgcn_exp2f(mrow[m] - mnew);
        lrow[m] *= alpha;
#pragma unroll
        for (int n = 0; n < ND; n++) O[m][n] *= alpha;
        mrow[m] = mnew;
      }
      float sum = 0.f;
#pragma unroll
      for (int n = 0; n < NKT; n++)
#pragma unroll
        for (int j = 0; j < 4; j++) {
          float pv = __builtin_amdgcn_exp2f(sT[m][n][j] - mnew);
          sT[m][n][j] = pv;
          sum += pv;
        }
      sum += __shfl_xor(sum, 16);
      sum += __shfl_xor(sum, 32);
      lrow[m] += sum;
#pragma unroll
      for (int t = 0; t < NTS; t++) {
        u32x4 pk;
        pk[0] = pack2(sT[m][2 * t][0], sT[m][2 * t][1]);
        pk[1] = pack2(sT[m][2 * t][2], sT[m][2 * t][3]);
        pk[2] = pack2(sT[m][2 * t + 1][0], sT[m][2 * t + 1][1]);
        pk[3] = pack2(sT[m][2 * t + 1][2], sT[m][2 * t + 1][3]);
        pb[m][t] = __builtin_bit_cast(bf16x8, pk);
      }
    }
#pragma unroll
    for (int t = 0; t < NTS; t++) {
#pragma unroll
      for (int n = 0; n < ND; n++) {
        const int k0 = kw + 32 * t + fq * 4;
        const char* vrow = sVc + (n * 16 + fr) * 128 + (k0 & 7) * 2;
        u32x2 lo = *(const u32x2*)(vrow + ((((k0 >> 3)) ^ (fr & 7)) & 7) * 16);
        u32x2 hi = *(const u32x2*)(vrow + ((((k0 >> 3) + 2) ^ (fr & 7)) & 7) * 16);
        u32x4 va = {lo[0], lo[1], hi[0], hi[1]};
        bf16x8 vaf = __builtin_bit_cast(bf16x8, va);
#pragma unroll
        for (int m = 0; m < MT; m++) O[m][n] = MFMA(vaf, pb[m][t], O[m][n]);
      }
    }
  }
  __builtin_amdgcn_s_barrier();
  const int tid2 = otid(), w2 = tid2 >> 6, fr2 = tid2 & 15, fq2 = (tid2 >> 4) & 3;
#pragma unroll
  for (int m = 0; m < MT; m++) {
    float il = 1.f / lrow[m];
    int row = w2 * 16 * MT + m * 16 + fr2;
#pragma unroll
    for (int n = 0; n < ND; n++) {
      u32x2* dp = (u32x2*)(obase + (size_t)row * ldo + n * 16 + fq2 * 4);
      u32x2 zz = *dp, o;
      o.x = pack2(O[m][n][0] * il * bf2f((u16)(zz.x & 0xffff)), O[m][n][1] * il * __uint_as_float(zz.x & 0xffff0000u));
      o.y = pack2(O[m][n][2] * il * bf2f((u16)(zz.y & 0xffff)), O[m][n][3] * il * __uint_as_float(zz.y & 0xffff0000u));
      *dp = o;
    }
  }
}

constexpr int N_DN = BP * 4 * 2 * 4, N_ML = N_DN, N_GA = BP * 4 * 16, N_NA = BP * 8 * 32;
__device__ __forceinline__ void phase_M(const Params& p, int l, int* ctr, char* smem) {
  const int xcd = blockIdx.x & 7;
  volatile LAS int* s_item_p = ((volatile LAS int*)&g_xb_words) + 2;
  constexpr int Q_DN = N_DN / 8, Q_ML = N_ML / 8, Q_GA = N_GA / 8, Q_NA = N_NA / 8;
  for (;;) {
    if (threadIdx.x == 0) *s_item_p = atomicAdd(ctr + xcd, 1);
    __syncthreads();
    int q = *s_item_p;
    __syncthreads();
    if (q >= Q_DN + Q_ML + Q_GA + Q_NA) break;
    if (q < Q_DN) q = q;
    else if (q < Q_DN + Q_GA / 2) q = Q_DN + Q_ML + (q - Q_DN);
    else if (q < Q_DN + Q_GA / 2 + Q_ML) q = Q_DN + (q - Q_DN - Q_GA / 2);
    else if (q < Q_DN + Q_ML + Q_GA) q = Q_DN + Q_ML + Q_GA / 2 + (q - Q_DN - Q_GA / 2 - Q_ML);
    if (q < Q_DN) {
      dn_scan_item(p, ((q >> 2) * 8 + xcd) * 4 + (q & 3), smem);
    } else if (q < Q_DN + Q_ML) {
      int u = q - Q_DN;
      ml_scan_item(p, l, ((u >> 2) * 8 + xcd) * 4 + (u & 3), smem);
    } else if (q < Q_DN + Q_ML + Q_GA) {
      int u = q - Q_DN - Q_ML;
      int grp = (u >> 5) * 8 + xcd, bl = grp >> 1, kvh = grp & 1, v = u & 31, hq = kvh * 2 + (v >> 4), qb = v & 15;
      u16* base = p.Cqkv + (size_t)bl * SEQ * 768;
      attn_item<128, 2, false>(base + (size_t)qb * 128 * 768 + hq * 128, 768, base + 512 + kvh * 128, 768,
                               p.VtC + (size_t)(bl * 2 + kvh) * 128 * SEQ,
                               p.Z + ((size_t)bl * SEQ + qb * 128) * 2560 + 1024 + hq * 128, 2560, 32, 0.08838834764831845f, 0, 0,
                               nullptr, smem);
    } else {
      int u = q - Q_DN - Q_ML - Q_GA;
      int grp = (u >> 5) * 8 + xcd, bl = grp >> 3, h = grp & 7, r = u & 31;
      int r0 = min(max(r - 4, 0), 24);
      u16* base = p.Bqkv + (size_t)bl * SEQ * 1024;
      attn_item<64, 1, true>(base + (size_t)r * 64 * 1024 + h * 64, 1024, base + (size_t)r0 * 64 * 1024 + 512 + h * 64, 1024,
                             p.VtB + (size_t)(bl * 8 + h) * 64 * SEQ + r0 * 64,
                             p.Z + ((size_t)bl * SEQ + r * 64) * 2560 + 512 + h * 64, 2560, 8, 0.125f, r, r0,
                             p.na_rpb + ((size_t)l * 8 + h) * 15 * 31, smem);
    }
  }
}

__device__ __forceinline__ void phase_F1(const Params& p, int l) {
  const int tid_ = otid(), lane = tid_ & 63, gw = blockIdx.x * 4 + (tid_ >> 6), nw = gridDim.x * 4;
  const u16* of = p.Aqkv;
  const u16* ob = p.Aqkv + (size_t)TH * 512;
  const u16* hf = p.Aqkv + (size_t)2 * TH * 512;
  const u16* hb = p.MLhb;
  for (int t = gw; t < TH; t += nw) {
    u16* z = p.Z + (size_t)t * 2560;
    const int e0 = lane * 8;
    float y[8];
    {
      u32x4 a = *(const u32x4*)(of + (size_t)t * 512 + e0), b = *(const u32x4*)(ob + (size_t)t * 512 + e0);
      u32x4 zz = *(const u32x4*)(z + e0);
      const u16 *pa = (const u16*)&a, *pb = (const u16*)&b, *pz = (const u16*)&zz;
      float ss = 0.f;
#pragma unroll
      for (int e = 0; e < 8; e++) { y[e] = bf2f(pa[e]) + bf2f(pb[e]); ss += y[e] * y[e]; }
      ss = grp16_sum(ss);
      float sc = rsqrtf(ss * (1.f / 128.f) + EPS);
      u32x4 ov;
      u16* o = (u16*)&ov;
#pragma unroll
      for (int e = 0; e < 8; e++) o[e] = f2bf(y[e] * sc * p.dn_norm_g[l * 128 + ((e0 + e) & 127)] * bf2f(pz[e]));
      *(u32x4*)(z + e0) = ov;
    }
    {
      u32x4 a = *(const u32x4*)(hf + (size_t)t * 512 + e0), b = *(const u32x4*)(hb + (size_t)t * 512 + e0);
      u32x4 zz = *(const u32x4*)(z + 1536 + e0), oz = *(const u32x4*)(z + 2048 + e0);
      const u16 *pa = (const u16*)&a, *pb = (const u16*)&b, *pz = (const u16*)&zz, *po = (const u16*)&oz;
      float ss = 0.f;
#pragma unroll
      for (int e = 0; e < 8; e++) { y[e] = bf2f(pa[e]) + bf2f(pb[e]); ss += y[e] * y[e]; }
      ss = grp16_sum(ss);
      float sc = rsqrtf(ss * (1.f / 128.f) + EPS);
      u32x4 ov;
      u16* o = (u16*)&ov;
#pragma unroll
      for (int e = 0; e < 8; e++)
        o[e] = f2bf(y[e] * sc * p.ml_norm_g[l * 128 + ((e0 + e) & 127)] * bf2f(pz[e]) * bf2f(po[e]));
      *(u32x4*)(z + 1536 + e0) = ov;
    }
  }
}

__device__ __forceinline__ void phase_F3(const Params& p, int l, char* smem) {
  const int tid = otid(), lane = tid & 63, w = tid >> 6, wm = w >> 1, wn = w & 1, fr = lane & 15, fq = lane >> 4;
  const u16* Wg = p.WinT + ((size_t)l * NWIN + NW1) * D;
  const u16* Wb = p.WbT + (size_t)l * 4 * D * 512;
  u16* merged = p.qkvc;
  constexpr int NT = 8, MTL = TH / 128;
  for (int id = blockIdx.x; id < NT * MTL; id += gridDim.x) {
    int mt, nt;
    tile_of(id, NT * MTL, NT, mt, nt);
    f32x4 accm[4][4];
    ZERO_ACC2(accm, 4, 4);
    for (int n = 0; n < 4; n++) {
      u32x2 gpk[4][4];
      {
        f32x4 accg[4][4];
        ZERO_ACC2(accg, 4, 4);
        gemm_dma<4, 4, true>(accg, p.hbuf + (size_t)mt * 128 * D, D, Wg + ((size_t)n * 1024 + nt * 128) * D, D, D, smem);
#pragma unroll
        for (int m = 0; m < 4; m++)
#pragma unroll
          for (int nn = 0; nn < 4; nn++) {
            float g0 = fmaxf(sigmoidf_(accg[m][nn][0]), 1e-6f), g1 = fmaxf(sigmoidf_(accg[m][nn][1]), 1e-6f);
            float g2 = fmaxf(sigmoidf_(accg[m][nn][2]), 1e-6f), g3 = fmaxf(sigmoidf_(accg[m][nn][3]), 1e-6f);
            gpk[m][nn].x = pack2(g0, g1);
            gpk[m][nn].y = pack2(g2, g3);
            accm[m][nn][0] = accm[m][nn][0] / bf2f((u16)(gpk[m][nn].x & 0xffff));
            accm[m][nn][1] = accm[m][nn][1] / bf2f((u16)(gpk[m][nn].x >> 16));
            accm[m][nn][2] = accm[m][nn][2] / bf2f((u16)(gpk[m][nn].y & 0xffff));
            accm[m][nn][3] = accm[m][nn][3] / bf2f((u16)(gpk[m][nn].y >> 16));
          }
      }
      gemm_dma<4, 4, true>(accm, p.Z + (size_t)mt * 128 * 2560 + n * 512, 2560, Wb + ((size_t)n * 1024 + nt * 128) * 512,
                           512, 512, smem);
#pragma unroll
      for (int m = 0; m < 4; m++)
#pragma unroll
        for (int nn = 0; nn < 4; nn++) {
          accm[m][nn][0] *= bf2f((u16)(gpk[m][nn].x & 0xffff));
          accm[m][nn][1] *= bf2f((u16)(gpk[m][nn].x >> 16));
          accm[m][nn][2] *= bf2f((u16)(gpk[m][nn].y & 0xffff));
          accm[m][nn][3] *= bf2f((u16)(gpk[m][nn].y >> 16));
        }
    }
    {
      const int te = otid(), fr = te & 15, fq = (te >> 4) & 3, wm = te >> 7, wn = (te >> 6) & 1;
#pragma unroll
      for (int m = 0; m < 4; m++)
#pragma unroll
        for (int nn = 0; nn < 4; nn++) {
          const int row = mt * 128 + wm * 64 + m * 16 + fr, col0 = nt * 128 + wn * 64 + nn * 16 + fq * 4;
          u32x2 o;
          o.x = pack2(accm[m][nn][0], accm[m][nn][1]);
          o.y = pack2(accm[m][nn][2], accm[m][nn][3]);
          *(u32x2*)(merged + (size_t)row * D + col0) = o;
        }
    }
  }
}

__device__ __forceinline__ void phase_F4(const Params& p, int l, const float* __restrict__ xin,
                                         float* __restrict__ xout, char* smem) {
  const int tid = otid(), lane = tid & 63, w = tid >> 6, wm = w >> 1, wn = w & 1, fr = lane & 15, fq = lane >> 4;
  const u16* Wo = p.WoT + (size_t)l * D * D;
  const u16* merged = p.qkvc;
  constexpr int NT = 8, MTL = TH / 256;
  for (int id = blockIdx.x; id < NT * MTL; id += gridDim.x) {
    int mt, nt;
    tile_of(id, NT * MTL, NT, mt, nt);
    f32x4 acc[8][4];
    ZERO_ACC2(acc, 8, 4);
    gemm_dma<8, 4, true>(acc, merged + (size_t)mt * 256 * D, D, Wo + (size_t)nt * 128 * D, D, D, smem);
    {
      const int te = otid(), fr = te & 15, fq = (te >> 4) & 3, wm = te >> 7, wn = (te >> 6) & 1;
#pragma unroll
      for (int m = 0; m < 8; m++)
#pragma unroll
        for (int nn = 0; nn < 4; nn++) {
          const size_t off = (size_t)(mt * 256 + wm * 128 + m * 16 + fr) * D + nt * 128 + wn * 64 + nn * 16 + fq * 4;
          f32x4 xi = *(const f32x4*)(xin + off);
          *(f32x4*)(xout + off) = xi + acc[m][nn];
        }
    }
  }
}

#define XB_TMO 128
#define XB_XCNT(j) (256 + 64 * (j))
#define XB_XSUB(j) (1280 + 64 * (j))
#define XB_XGEN(j) (2304 + 64 * (j))
#define XB_TOP 3328
#define XB_TOPGEN 3392
#define XCD_BAR_WORDS 3456
#define XB_SPIN_CAP (1u << 20)
__device__ __forceinline__ unsigned xb_ld(unsigned* p) { return __hip_atomic_load(p, __ATOMIC_RELAXED, __HIP_MEMORY_SCOPE_AGENT); }
__device__ __forceinline__ unsigned xb_add(unsigned* p, unsigned v) {
  return __hip_atomic_fetch_add(p, v, __ATOMIC_RELAXED, __HIP_MEMORY_SCOPE_AGENT);
}
__device__ __forceinline__ unsigned xb_xcc_id() { return (unsigned)__builtin_amdgcn_s_getreg((3 << 11) | 20) & 0xFu; }
#define XB_SPIN(cond, bar)                                                      \
  do {                                                                          \
    unsigned _sp = 0;                                                           \
    while (cond) {                                                              \
      __builtin_amdgcn_s_sleep(1);                                              \
      if ((++_sp & 255u) == 0u) {                                               \
        if (xb_ld(&(bar)[XB_TMO])) break;                                       \
        if (_sp > XB_SPIN_CAP) { atomicAdd(&(bar)[XB_TMO], 1u); break; }        \
      }                                                                         \
    }                                                                           \
  } while (0)
struct XcdBarrier { unsigned* bar; };
__device__ __forceinline__ XcdBarrier xcd_barrier_post(unsigned* bar) {
  XcdBarrier b; b.bar = bar;
  if (threadIdx.x == 0) (void)xb_add(&bar[XB_XCNT(xb_xcc_id())], 1u);
  return b;
}
__device__ __forceinline__ void xcd_barrier_complete(unsigned* bar, unsigned x, unsigned& nloc, unsigned& nx) {
  const unsigned G = gridDim.x * gridDim.y * gridDim.z;
  unsigned sum, cnt, mine, sp = 0u;
  for (;;) {
    sum = 0u; cnt = 0u; mine = 0u;
#pragma unroll
    for (unsigned j = 0; j < 16; ++j) {
      const unsigned c = xb_ld(&bar[XB_XCNT(j)]);
      sum += c; cnt += (c > 0u) ? 1u : 0u; mine = (j == x) ? c : mine;
    }
    if (sum == G) break;
    __builtin_amdgcn_s_sleep(1);
    if ((++sp & 255u) == 0u) {
      if (xb_ld(&bar[XB_TMO])) break;
      if (sp > XB_SPIN_CAP) { atomicAdd(&bar[XB_TMO], 1u); break; }
    }
  }
  nloc = mine > 0u ? mine : 1u; nx = cnt > 0u ? cnt : 1u;
}
__device__ __forceinline__ void xcd_barrier(const XcdBarrier& b) {
  asm volatile("s_waitcnt vmcnt(0)" ::: "memory");
  __syncthreads();
  if (threadIdx.x == 0) {
    unsigned* bar = b.bar;
    __builtin_amdgcn_s_waitcnt(0);
    volatile LAS unsigned* st = (volatile LAS unsigned*)&g_xb_words;
    const unsigned bx = xb_xcc_id();
    unsigned nloc = st[0], nx = st[1];
    if (nloc == 0u) { xcd_barrier_complete(bar, bx, nloc, nx); st[0] = nloc; st[1] = nx; }
    const unsigned old = xb_add(&bar[XB_XSUB(bx)], 1u);
    const unsigned gen = old / nloc;
    if (old + 1u == (gen + 1u) * nloc) {
      __builtin_amdgcn_fence(__ATOMIC_RELEASE, "agent");
      asm volatile("s_waitcnt vmcnt(0)" ::: "memory");
      const unsigned og = xb_add(&bar[XB_TOP], 1u);
      const unsigned tg = og / nx;
      if (og + 1u == (tg + 1u) * nx) xb_add(&bar[XB_TOPGEN], 1u);
      else XB_SPIN(xb_ld(&bar[XB_TOPGEN]) == tg, bar);
      __builtin_amdgcn_fence(__ATOMIC_ACQUIRE, "agent");
      xb_add(&bar[XB_XGEN(bx)], 1u);
      asm volatile("s_waitcnt vmcnt(0)" ::: "memory");
    } else {
      XB_SPIN(xb_ld(&bar[XB_XGEN(bx)]) == gen, bar);
      __builtin_amdgcn_fence(__ATOMIC_ACQUIRE, "agent");
      asm volatile("s_waitcnt vmcnt(0)" ::: "memory");
    }
  }
  __syncthreads();
}

__global__ void __launch_bounds__(256, 2) mega(Params p) {
  cg::grid_group grid = cg::this_grid();
  extern __shared__ __attribute__((aligned(16))) char smem[];
  if (threadIdx.x == 0) g_xb_words = make_uint4(0u, 0u, 0u, 0u);
  __syncthreads();
  XcdBarrier xb = xcd_barrier_post(p.bar);
  if (p.use_cg) grid.sync();
#ifndef DUP
#define DUP 0
#endif
  phase_W(p, smem);
  xcd_barrier(xb);
  if (DUP == 6) { phase_W(p, smem); xcd_barrier(xb); }
  for (int l = 0; l < DEPTH; l++) {
    for (int ps = 0; ps < NPASS; ps++) {
      const float* xin = (l == 0 ? p.x : p.out) + (size_t)ps * TH * D;
      float* xout = p.out + (size_t)ps * TH * D;
      phase_R(xin, p.norm_g + l * D, p.hbuf);
      xcd_barrier(xb);
      if (DUP == 9) { phase_R(xin, p.norm_g + l * D, p.hbuf); xcd_barrier(xb); }
      if (DUP == 10) { xcd_barrier(xb); xcd_barrier(xb); xcd_barrier(xb); xcd_barrier(xb); xcd_barrier(xb); xcd_barrier(xb); xcd_barrier(xb); xcd_barrier(xb); }
      phase_G1(p, l, smem);
      xcd_barrier(xb);
      if (DUP == 1) { phase_G1(p, l, smem); xcd_barrier(xb); }
      phase_P2(p, l, smem);
      xcd_barrier(xb);
      if (DUP == 4) { for (int item = blockIdx.x; item < NCHK; item += gridDim.x) dn_prep_item(p, l, item, smem); xcd_barrier(xb); }
      if (DUP >= 80 && DUP < 90) { for (int it = blockIdx.x; it < N_ML; it += gridDim.x) ml_scan_item(p, l, it, smem, DUP - 80); xcd_barrier(xb); }
      phase_M(p, l, p.ctr + (l * NPASS + ps) * 8, smem);
      xcd_barrier(xb);
      if (DUP == 3) { phase_M(p, l, p.ctr + 64 + (l * NPASS + ps) * 8, smem); xcd_barrier(xb); }
      if (DUP == 7) { for (int it = blockIdx.x; it < N_DN; it += gridDim.x) dn_scan_item(p, it, smem); xcd_barrier(xb); }
      if (DUP == 8) { for (int it = blockIdx.x; it < N_ML; it += gridDim.x) ml_scan_item(p, l, it, smem); xcd_barrier(xb); }
      if (DUP == 5) {
        for (int it = blockIdx.x; it < N_DN + N_ML; it += gridDim.x) {
          if (it < N_DN) dn_scan_item(p, it, smem); else ml_scan_item(p, l, it - N_DN, smem);
        }
        xcd_barrier(xb);
      }
      phase_F1(p, l);
      xcd_barrier(xb);
      phase_F3(p, l, smem);
      xcd_barrier(xb);
      if (DUP == 2) { phase_F3(p, l, smem); xcd_barrier(xb); }
      phase_F4(p, l, xin, xout, smem);
      xcd_barrier(xb);
    }
  }
}

extern "C" void kernel_launch(void* const* d_in, const int* in_sizes, int n_in, void* d_out, int out_size,
                              void* d_ws, size_t ws_size, hipStream_t stream) {
  static int grid_blocks = 0;
  if (!grid_blocks) {
    (void)hipFuncSetAttribute((const void*)mega, hipFuncAttributeMaxDynamicSharedMemorySize, (int)LDS_BYTES);
    int dev = 0, cus = 0, per_cu = 0;
    (void)hipGetDevice(&dev);
    (void)hipDeviceGetAttribute(&cus, hipDeviceAttributeMultiprocessorCount, dev);
    (void)hipOccupancyMaxActiveBlocksPerMultiprocessor(&per_cu, mega, 256, LDS_BYTES);
    if (per_cu > 2) per_cu = 2;
    grid_blocks = cus * per_cu;
  }
  Params p{};
  const float* const* in = (const float* const*)d_in;
  p.x = in[0]; p.norm_g = in[1]; p.w_in = in[2]; p.conv_a = in[3]; p.dn_a_log = in[4]; p.dn_dt_bias = in[5];
  p.dn_norm_g = in[6]; p.na_q_norm = in[7]; p.na_k_norm = in[8]; p.na_rpb = in[9]; p.ga_q_norm = in[10];
  p.ga_k_norm = in[11]; p.ml_i_bias = in[12]; p.ml_f_bias = in[13]; p.ml_norm_g = in[14]; p.w_branch = in[15];
  p.w_out = in[16];
  p.out = (float*)d_out;
  char* ws = (char*)d_ws;
  size_t off = 0;
  auto take = [&](size_t bytes) { char* r = ws + off; off += (bytes + 255) & ~(size_t)255; return r; };
  p.ctr = (int*)take(1024);
  p.bar = (unsigned*)take(XCD_BAR_WORDS * 4);
  p.use_cg = 0; p.pad = 0;
  p.WinT = (u16*)take((size_t)DEPTH * NWIN * D * 2);
  p.WbT = (u16*)take((size_t)DEPTH * 4 * D * 512 * 2);
  p.WoT = (u16*)take((size_t)DEPTH * D * D * 2);
  p.hbuf = (u16*)take((size_t)TH * D * 2);
  p.Aqkv = (u16*)take((size_t)TH * 1536 * 2);
  p.Bqkv = (u16*)take((size_t)TH * 1024 * 2);
  p.Cqkv = (u16*)take((size_t)TH * 768 * 2);
  p.Dqkv = (u16*)take((size_t)TH * 1024 * 2);
  p.Z = (u16*)take((size_t)TH * 2560 * 2);
  p.Sm = (float*)take((size_t)TH * 32 * 4);
  p.qkvc = (u16*)take((size_t)TH * 1536 * 2);
  p.TP = (u16*)take((size_t)NCHK * 2 * 2 * 4096 * 2);
  p.KdT = (u16*)take((size_t)NCHK * 2 * 8192 * 2);
  p.vecs = (float*)take((size_t)NCHK * 2 * 144 * 4);
  p.MLhb = (u16*)take((size_t)TH * 512 * 2);
  p.Bo = (u16*)take((size_t)TH * 512 * 2);
  p.Co = (u16*)take((size_t)TH * 512 * 2);
  p.VtB = (u16*)take((size_t)TH * 512 * 2);
  p.VtC = (u16*)take((size_t)TH * 256 * 2);
  if (off > ws_size) return;
  (void)hipMemsetAsync(p.ctr, 0, 1024 + ((XCD_BAR_WORDS * 4 + 255) & ~255), stream);
  void* args[] = {&p};
  (void)hipLaunchCooperativeKernel((void*)mega, dim3(grid_blocks), dim3(256), args, LDS_BYTES, stream);
}
```
